# Optimizing an MI355X kernel written in HIP

```python
import math
import jax
import jax.numpy as jnp
from jax import lax
import numpy as np

D_MODEL = 1024
BATCH = 8
SEQ = 8192
DEPTH = 1
DEC_BATCH = 16
DEC_SEQ = 32
PAST_LEN = 2048

CHUNK = 64
D_SSM = D_MODEL // 2
SSM_GROUP_DIM = 16
SSM_GROUPS = D_SSM // SSM_GROUP_DIM
SSM_STATE = 64
D_POOL = D_MODEL // 2
POOL_WINDOWS = (2, 4, 8, 16)
POOL_GROUPS = len(POOL_WINDOWS)
POOL_GROUP_DIM = D_POOL // POOL_GROUPS
POOL_OUT_DIM = D_MODEL // POOL_GROUPS
POOL_MAXW = max(POOL_WINDOWS)
POOL_HIST = POOL_MAXW - 1
D_FF = 2816
D_IN_PROJ = D_SSM + D_POOL + 2 * D_MODEL
EPS = 1e-6
DT_MIN = 1e-3
DT_MAX = 1e-1

kernel_name = "gated_s5_pool_macaron_stream_step"


def rms_norm(x, g):
    xf = x.astype(jnp.float32)
    y = xf * lax.rsqrt(jnp.mean(xf * xf, axis=-1, keepdims=True) + EPS)
    return (y * g.astype(jnp.float32)).astype(x.dtype)


def swiglu(h, w_in, w_out):
    a, b = jnp.split(h @ w_in, 2, axis=-1)
    return (jax.nn.silu(a) * b) @ w_out


def _complex_scan_combine(e1, e2):
    a1r, a1i, b1r, b1i = e1
    a2r, a2i, b2r, b2i = e2
    return (a2r * a1r - a2i * a1i,
            a2r * a1i + a2i * a1r,
            a2r * b1r - a2i * b1i + b2r,
            a2r * b1i + a2i * b1r + b2i)


def s5_branch(u, h0_re, h0_im, lam_re, lam_im, log_step, b_re, b_im, c_re, c_im, d_skip, w_glu, b_glu):
    f32 = jnp.float32
    bsz, t_len, _ = u.shape
    uf = u.astype(f32)
    ug = uf.reshape(bsz, t_len, SSM_GROUPS, SSM_GROUP_DIM)
    lr = lam_re.astype(f32)
    li = lam_im.astype(f32)
    dt = jnp.exp(log_step.astype(f32))[:, None]
    mag = jnp.exp(lr * dt)
    ab_re = mag * jnp.cos(li * dt)
    ab_im = mag * jnp.sin(li * dt)
    den = lr * lr + li * li
    nr = ab_re - 1.0
    f_re = (nr * lr + ab_im * li) / den
    f_im = (ab_im * lr - nr * li) / den
    br = b_re.astype(f32)
    bi = b_im.astype(f32)
    bb_re = f_re[..., None] * br - f_im[..., None] * bi
    bb_im = f_re[..., None] * bi + f_im[..., None] * br
    v_re = jnp.einsum("btgc,gpc->tbgp", ug, bb_re)
    v_im = jnp.einsum("btgc,gpc->tbgp", ug, bb_im)
    if h0_re is not None:
        hr = h0_re.astype(f32)
        hi = h0_im.astype(f32)
        v_re = v_re.at[0].add(ab_re * hr - ab_im * hi)
        v_im = v_im.at[0].add(ab_re * hi + ab_im * hr)
    a_shape = (t_len, 1, SSM_GROUPS, SSM_STATE)
    a_re = jnp.broadcast_to(ab_re, a_shape)
    a_im = jnp.broadcast_to(ab_im, a_shape)
    _, _, s_re, s_im = lax.associative_scan(_complex_scan_combine, (a_re, a_im, v_re, v_im), axis=0)
    y = (jnp.einsum("tbgp,gcp->btgc", s_re, c_re.astype(f32))
         - jnp.einsum("tbgp,gcp->btgc", s_im, c_im.astype(f32)))
    y = y.reshape(bsz, t_len, D_SSM) + d_skip.astype(f32) * uf
    y = jax.nn.gelu(y).astype(u.dtype)
    a, g = jnp.split(y @ w_glu + b_glu, 2, axis=-1)
    return a * jax.nn.sigmoid(g), s_re[-1], s_im[-1]


def pool_branch(u, hist, pos0, pool_w, pool_scale):
    f32 = jnp.float32
    bsz, t_len, _ = u.shape
    n_hist = hist.shape[1]
    ext = jnp.concatenate([hist, u], axis=1).astype(f32)
    lead = jnp.zeros((bsz, POOL_MAXW, D_POOL), f32)
    cs = jnp.concatenate([lead, jnp.cumsum(ext, axis=1)], axis=1)
    start = POOL_MAXW + n_hist
    hi = cs[:, start:start + t_len]
    cur = ext[:, n_hist:]
    pos = pos0 + jnp.arange(t_len, dtype=jnp.int32)
    parts = []
    for gi, w in enumerate(POOL_WINDOWS):
        sl = slice(gi * POOL_GROUP_DIM, (gi + 1) * POOL_GROUP_DIM)
        lo = cs[:, start - w:start - w + t_len, sl]
        cnt = jnp.minimum(pos + 1, w).astype(f32)[None, :, None]
        parts.append((hi[..., sl] - lo) / cnt - cur[..., sl])
    pooled = jnp.stack(parts, axis=2)
    out = jnp.einsum("btgc,gco->btgo", pooled, pool_w.astype(f32))
    out = out.reshape(bsz, t_len, D_MODEL) * pool_scale.astype(f32)
    return out.astype(u.dtype)


def encoder_layer(x, h0_re, h0_im, hist, pos0, p):
    h = x + 0.5 * rms_norm(swiglu(rms_norm(x, p["ffn1_pre_g"]), p["ffn1_w_in"], p["ffn1_w_out"]), p["ffn1_post_g"])
    z = rms_norm(h, p["mix_pre_g"])
    proj = z @ p["w_in"] + p["b_in"]
    u_ssm = proj[..., :D_SSM]
    u_pool = proj[..., D_SSM:D_SSM + D_POOL]
    gates = jax.nn.sigmoid(proj[..., D_SSM + D_POOL:].astype(jnp.float32)).astype(x.dtype)
    g_ssm, g_pool = jnp.split(gates, 2, axis=-1)
    y_ssm, s_re, s_im = s5_branch(u_ssm, h0_re, h0_im, p["ssm_lambda_re"], p["ssm_lambda_im"], p["ssm_log_step"],
                                  p["ssm_b_re"], p["ssm_b_im"], p["ssm_c_re"], p["ssm_c_im"], p["ssm_d"],
                                  p["ssm_w_glu"], p["ssm_b_glu"])
    if hist is None:
        hist = u_pool[:, :0]
    y_pool = pool_branch(u_pool, hist, pos0, p["pool_w"], p["pool_scale"])
    merged = g_ssm * y_ssm + g_pool * y_pool
    h = h + rms_norm(merged @ p["w_out"], p["mix_post_g"])
    h = h + 0.5 * rms_norm(swiglu(rms_norm(h, p["ffn2_pre_g"]), p["ffn2_w_in"], p["ffn2_w_out"]), p["ffn2_post_g"])
    new_hist = jnp.concatenate([hist, u_pool], axis=1)[:, -POOL_HIST:]
    return h, s_re.astype(x.dtype), s_im.astype(x.dtype), new_hist


def setup_inputs(seed: int = 0) -> dict:
    key = jax.random.key(seed)
    ks = jax.random.split(key, 32)
    f32 = jnp.float32

    def nrm(k, shape, s):
        return s * jax.random.normal(k, shape, f32)

    def gain(k):
        return 1.0 + 0.05 * jax.random.normal(k, (DEPTH, D_MODEL), f32)

    n_idx = jnp.arange(SSM_STATE, dtype=f32)
    lam_re = -0.5 + 0.01 * jax.random.normal(ks[10], (DEPTH, SSM_GROUPS, SSM_STATE), f32)
    lam_im = jnp.pi * n_idx + 0.01 * jax.random.normal(ks[11], (DEPTH, SSM_GROUPS, SSM_STATE), f32)
    log_step = jax.random.uniform(ks[12], (DEPTH, SSM_GROUPS), f32, math.log(DT_MIN), math.log(DT_MAX))
    return {
        "x_prompt": nrm(ks[0], (BATCH, SEQ, D_MODEL), 1.0),
        "x_sample": nrm(ks[1], (DEC_BATCH, DEC_SEQ, D_MODEL), 1.0),
        "state_ssm_re": nrm(ks[2], (DEPTH, DEC_BATCH, SSM_GROUPS, SSM_STATE), 0.5),
        "state_ssm_im": nrm(ks[3], (DEPTH, DEC_BATCH, SSM_GROUPS, SSM_STATE), 0.5),
        "cache_pool": nrm(ks[4], (DEPTH, DEC_BATCH, POOL_HIST, D_POOL), 1.0),
        "ffn1_pre_g": gain(ks[5]),
        "ffn1_w_in": nrm(ks[6], (DEPTH, D_MODEL, 2 * D_FF), D_MODEL ** -0.5),
        "ffn1_w_out": nrm(ks[7], (DEPTH, D_FF, D_MODEL), D_FF ** -0.5),
        "ffn1_post_g": gain(ks[8]),
        "mix_pre_g": gain(ks[9]),
        "w_in": nrm(ks[13], (DEPTH, D_MODEL, D_IN_PROJ), D_MODEL ** -0.5),
        "b_in": nrm(ks[14], (DEPTH, D_IN_PROJ), 0.02),
        "ssm_lambda_re": lam_re,
        "ssm_lambda_im": lam_im,
        "ssm_log_step": log_step,
        "ssm_b_re": nrm(ks[15], (DEPTH, SSM_GROUPS, SSM_STATE, SSM_GROUP_DIM), (2 * SSM_GROUP_DIM) ** -0.5),
        "ssm_b_im": nrm(ks[16], (DEPTH, SSM_GROUPS, SSM_STATE, SSM_GROUP_DIM), (2 * SSM_GROUP_DIM) ** -0.5),
        "ssm_c_re": nrm(ks[17], (DEPTH, SSM_GROUPS, SSM_GROUP_DIM, SSM_STATE), (2 * SSM_STATE) ** -0.5),
        "ssm_c_im": nrm(ks[18], (DEPTH, SSM_GROUPS, SSM_GROUP_DIM, SSM_STATE), (2 * SSM_STATE) ** -0.5),
        "ssm_d": nrm(ks[19], (DEPTH, D_SSM), 1.0),
        "ssm_w_glu": nrm(ks[20], (DEPTH, D_SSM, 2 * D_MODEL), D_SSM ** -0.5),
        "ssm_b_glu": nrm(ks[21], (DEPTH, 2 * D_MODEL), 0.02),
        "pool_w": nrm(ks[22], (DEPTH, POOL_GROUPS, POOL_GROUP_DIM, POOL_OUT_DIM), POOL_GROUP_DIM ** -0.5),
        "pool_scale": 1.0 + 0.1 * jax.random.normal(ks[23], (DEPTH, D_MODEL), f32),
        "w_out": nrm(ks[24], (DEPTH, D_MODEL, D_MODEL), D_MODEL ** -0.5),
        "mix_post_g": gain(ks[25]),
        "ffn2_pre_g": gain(ks[26]),
        "ffn2_w_in": nrm(ks[27], (DEPTH, D_MODEL, 2 * D_FF), D_MODEL ** -0.5),
        "ffn2_w_out": nrm(ks[28], (DEPTH, D_FF, D_MODEL), D_FF ** -0.5),
        "ffn2_post_g": gain(ks[29]),
    }


def reference(x_prompt, x_sample, state_ssm_re, state_ssm_im, cache_pool,
              ffn1_pre_g, ffn1_w_in, ffn1_w_out, ffn1_post_g, mix_pre_g, w_in, b_in,
              ssm_lambda_re, ssm_lambda_im, ssm_log_step, ssm_b_re, ssm_b_im, ssm_c_re, ssm_c_im,
              ssm_d, ssm_w_glu, ssm_b_glu, pool_w, pool_scale, w_out, mix_post_g,
              ffn2_pre_g, ffn2_w_in, ffn2_w_out, ffn2_post_g):
    hp = x_prompt
    hs = x_sample
    pr_re, pr_im, pr_pool, sm_re, sm_im, sm_pool = [], [], [], [], [], []
    for l in range(DEPTH):
        p = {
            "ffn1_pre_g": ffn1_pre_g[l], "ffn1_w_in": ffn1_w_in[l], "ffn1_w_out": ffn1_w_out[l],
            "ffn1_post_g": ffn1_post_g[l], "mix_pre_g": mix_pre_g[l], "w_in": w_in[l], "b_in": b_in[l],
            "ssm_lambda_re": ssm_lambda_re[l], "ssm_lambda_im": ssm_lambda_im[l],
            "ssm_log_step": ssm_log_step[l], "ssm_b_re": ssm_b_re[l], "ssm_b_im": ssm_b_im[l],
            "ssm_c_re": ssm_c_re[l], "ssm_c_im": ssm_c_im[l], "ssm_d": ssm_d[l],
            "ssm_w_glu": ssm_w_glu[l], "ssm_b_glu": ssm_b_glu[l], "pool_w": pool_w[l],
            "pool_scale": pool_scale[l], "w_out": w_out[l], "mix_post_g": mix_post_g[l],
            "ffn2_pre_g": ffn2_pre_g[l], "ffn2_w_in": ffn2_w_in[l], "ffn2_w_out": ffn2_w_out[l],
            "ffn2_post_g": ffn2_post_g[l],
        }
        hp, s_re, s_im, s_pool = encoder_layer(hp, None, None, None, 0, p)
        pr_re.append(s_re)
        pr_im.append(s_im)
        pr_pool.append(s_pool)
        hs, s_re, s_im, s_pool = encoder_layer(hs, state_ssm_re[l], state_ssm_im[l], cache_pool[l], PAST_LEN, p)
        sm_re.append(s_re)
        sm_im.append(s_im)
        sm_pool.append(s_pool)
    return (hp, hs, jnp.stack(pr_re), jnp.stack(pr_im), jnp.stack(pr_pool),
            jnp.stack(sm_re), jnp.stack(sm_im), jnp.stack(sm_pool))
```

```cpp
#include <hip/hip_runtime.h>
#include <hip/hip_cooperative_groups.h>
#include <cstdio>
namespace pg8 {
#define PG8_LAS __attribute__((address_space(3)))
typedef unsigned short bf16_t;
typedef short bf16x8 __attribute__((ext_vector_type(8)));
typedef float f32x4 __attribute__((ext_vector_type(4)));
typedef unsigned u32x4 __attribute__((ext_vector_type(4)));
constexpr int BM = 256, BK = 64, HALF = 128, HTB = HALF * BK * 2  , STAGE_BYTES = 8 * HTB, NXCD = 8, WGM = 8;

__host__ __device__ __forceinline__ int lds_byte(int r, int c) { const int st = (r >> 4) * 2 + (c >> 5), rr = r & 15, cc = c & 31, ob = rr * 64 + cc * 2; return st * 1024 + (ob ^ (((ob >> 9) & 1) << 5)); }
__host__ __device__ __forceinline__ void stage_rc(int b, int& R, int& C) { const int st = b / 1024, sb = b % 1024, swz = sb ^ (((sb >> 9) & 1) << 5); R = (st >> 1) * 16 + swz / 64; C = (st & 1) * 32 + (swz % 64) / 2; }
__host__ __device__ __forceinline__ int perm32(int rho) { const int n = rho >> 4, i = rho & 15; return 8 * (i >> 2) + 4 * n + (i & 3); }

struct Unit { int pm, pn; };
struct Gemm { const bf16_t* A; const bf16_t* Bt; int M, N, K; };

struct StaticOrder {
    int nM, nN, nwg, G, c;
    __host__ __device__ void init(int M, int N, int G_, int c_) { nM = M / BM; nN = N / BM; nwg = nM * nN; G = G_; c = c_; }
    __host__ __device__ bool next(int i, Unit& u) const {
        const long L = (long)i * G + c; if (L >= nwg) return false;
        int wgid = (int)L; { const int q = nwg / NXCD, r = nwg % NXCD, xcd = wgid % NXCD, off = wgid / NXCD; wgid = (xcd < r ? xcd * (q + 1) : r * (q + 1) + (xcd - r) * q) + off; }
        const int nig = WGM * nN, gid = wgid / nig, fm = gid * WGM, gsz = (nM - fm) < WGM ? (nM - fm) : WGM;
        u.pm = fm + ((wgid % nig) % gsz); u.pn = (wgid % nig) / gsz; return true;
    }
    __device__ __forceinline__ void a_ready(const Unit&) const {}
    __device__ __forceinline__ void done(const Unit&) const {}
};
typedef float f32x2c __attribute__((ext_vector_type(2))); typedef __bf16 bf16x2c __attribute__((ext_vector_type(2)));
__device__ __forceinline__ unsigned cvt_pk_bf16(float lo, float hi) { const f32x2c f = {lo, hi}; const bf16x2c b = __builtin_convertvector(f, bf16x2c); return __builtin_bit_cast(unsigned, b); }
typedef float f32x2 __attribute__((ext_vector_type(2)));
template <class Epi, class Sched, bool STAMP = false>
__device__ __forceinline__ void gemm_phase(PG8_LAS unsigned char* lds, const Gemm g, const Sched& S, const Epi& E, unsigned long long* stamps) {
    int tid_; asm volatile("v_mov_b32 %0, %1" : "=v"(tid_) : "v"((int)threadIdx.x)); const int tid = tid_, wid = __builtin_amdgcn_readfirstlane(tid >> 6), lane = tid & 63, wr = wid >> 2, wc = wid & 3, fr = lane & 15, fq = lane >> 4;
    const int K = g.K, nt = K / BK;
    int ts_lo = 0, ts_hi = 0, nts = 0; const unsigned long long rt_entry = STAMP ? (unsigned long long)wall_clock64() : 0ull;
#define PG8_STAMP() do { if (STAMP && wid == 0 && nts < 64) { const unsigned long long _c = (unsigned long long)clock64(); \
        ts_lo = (lane == nts) ? (int)(unsigned)_c : ts_lo; ts_hi = (lane == nts) ? (int)(unsigned)(_c >> 32) : ts_hi; ++nts; } } while (0)
    PG8_STAMP();
    unsigned voffA[2], voffB[2];
#pragma unroll
    for (int i = 0; i < 2; ++i) { int R, C; stage_rc(tid * 16 + i * 8192, R, C); const int Rb = Epi::PERM ? ((R & ~31) + perm32(R & 31)) : R;
        voffA[i] = (unsigned)(R * K + C) * 2u; voffB[i] = (unsigned)(Rb * K + C) * 2u; }
    const size_t kstep = (size_t)(BK * 2);
    const size_t hstep = (size_t)HALF * K * 2;
    const size_t tstep = 2 * hstep;
    const unsigned ldsw = (unsigned)wid * 1024u;
    const int aoff = lds_byte(wr * 64 + fr, fq * 8), boff = lds_byte(wc * 32 + fr, fq * 8);
#define PG8_SA(b, h) (((b) * 2 + (h)) * HTB)
#define PG8_SB(b, h) ((4 + (b) * 2 + (h)) * HTB)
#define PG8_STAGE(bufoff, gbase, voff) do { _Pragma("unroll") for (int _i = 0; _i < 2; ++_i) \
        __builtin_amdgcn_global_load_lds((const unsigned*)((const char*)(gbase) + (voff)[_i]), (PG8_LAS unsigned*)(lds + (bufoff) + ldsw + _i * 8192), 16, 0, 0); } while (0)
#define PG8_LDA(dst, b, h) do { _Pragma("unroll") for (int m = 0; m < 4; ++m) _Pragma("unroll") for (int k = 0; k < 2; ++k) dst[m][k] = *(const PG8_LAS bf16x8*)(lds + PG8_SA(b, h) + aoff + m * 2048 + k * 1024); } while (0)
#define PG8_LDB(dst, b, h) do { _Pragma("unroll") for (int n = 0; n < 2; ++n) _Pragma("unroll") for (int k = 0; k < 2; ++k) dst[n][k] = *(const PG8_LAS bf16x8*)(lds + PG8_SB(b, h) + boff + n * 2048 + k * 1024); } while (0)
#define PG8_MMA(ai, bj, At, Bt) do { __builtin_amdgcn_s_setprio(1); _Pragma("unroll") for (int m = 0; m < 4; ++m) _Pragma("unroll") for (int n = 0; n < 2; ++n) _Pragma("unroll") for (int k = 0; k < 2; ++k) \
        acc[ai][bj][m][n] = __builtin_amdgcn_mfma_f32_16x16x32_bf16(Bt[n][k], At[m][k], acc[ai][bj][m][n], 0, 0, 0); __builtin_amdgcn_s_setprio(0); } while (0)
#define PG8_WAIT_V(n) asm volatile("s_waitcnt vmcnt(" #n ")" ::: "memory")
#define PG8_WAIT_L(n) asm volatile("s_waitcnt lgkmcnt(" #n ")" ::: "memory")
#define PG8_BAR __builtin_amdgcn_s_barrier()
#define PG8_SCHED __builtin_amdgcn_sched_barrier(0)
    Unit cur, nxt; int ui = 0;
    if (!S.next(0, cur)) return;
    f32x4 acc[2][2][4][2];
#pragma unroll
    for (int a = 0; a < 2; ++a)
#pragma unroll
        for (int b = 0; b < 2; ++b)
#pragma unroll
            for (int m = 0; m < 4; ++m)
#pragma unroll
                for (int n = 0; n < 2; ++n) acc[a][b][m][n] = (f32x4){0.f, 0.f, 0.f, 0.f};
    bf16x8 At[4][2], B0[2][2], B1[2][2];
    const char* cA = (const char*)g.A + (size_t)cur.pm * tstep; const char* cB = (const char*)g.Bt + (size_t)cur.pn * tstep;
    S.a_ready(cur);
    PG8_STAGE(PG8_SB(0, 0), cB, voffB); PG8_STAGE(PG8_SA(0, 0), cA, voffA); PG8_STAGE(PG8_SB(0, 1), cB + hstep, voffB); PG8_STAGE(PG8_SA(0, 1), cA + hstep, voffA);
    if (wr == 1) PG8_BAR;
    PG8_WAIT_V(4); PG8_BAR;
    PG8_STAGE(PG8_SB(1, 0), cB + kstep, voffB); PG8_STAGE(PG8_SA(1, 0), cA + kstep, voffA); PG8_STAGE(PG8_SB(1, 1), cB + hstep + kstep, voffB);
    PG8_WAIT_V(6); PG8_BAR;
    PG8_STAMP();
    for (;;) {
        const bool has_next = S.next(ui + 1, nxt);
        const char* nA = has_next ? (const char*)g.A + (size_t)nxt.pm * tstep : cA; const char* nB = has_next ? (const char*)g.Bt + (size_t)nxt.pn * tstep : cB;
        for (int t = 0; t < nt; t += 2) {
            const bool last = (t == nt - 2);
            const char* a1 = cA + (size_t)(t + 1) * kstep;
            const char* a2 = last ? nA : cA + (size_t)(t + 2) * kstep; const char* b2 = last ? nB : cB + (size_t)(t + 2) * kstep;
            const char* a3 = a2 + kstep; const char* b3 = b2 + kstep;
            if (last && has_next) S.a_ready(nxt);
            PG8_LDB(B0, 0, 0); PG8_SCHED; PG8_LDA(At, 0, 0); PG8_STAGE(PG8_SA(1, 1), a1 + hstep, voffA);
            PG8_WAIT_L(8); PG8_BAR; PG8_WAIT_L(0); PG8_MMA(0, 0, At, B0); PG8_BAR; PG8_SCHED;
            PG8_LDB(B1, 0, 1); PG8_STAGE(PG8_SB(0, 0), b2, voffB);
            PG8_BAR; PG8_WAIT_L(0); PG8_MMA(0, 1, At, B1); PG8_BAR;
            PG8_LDA(At, 0, 1); PG8_STAGE(PG8_SA(0, 0), a2, voffA);
            PG8_BAR; PG8_WAIT_L(0); PG8_MMA(1, 0, At, B0); PG8_BAR; PG8_SCHED;
            PG8_STAGE(PG8_SB(0, 1), b2 + hstep, voffB);
            PG8_WAIT_V(6); PG8_BAR; PG8_MMA(1, 1, At, B1); PG8_BAR;
            PG8_LDB(B0, 1, 0); PG8_SCHED; PG8_LDA(At, 1, 0); PG8_STAGE(PG8_SA(0, 1), a2 + hstep, voffA);
            PG8_WAIT_L(8); PG8_BAR; PG8_WAIT_L(0); PG8_MMA(0, 0, At, B0); PG8_BAR; PG8_SCHED;
            PG8_LDB(B1, 1, 1); PG8_STAGE(PG8_SB(1, 0), b3, voffB);
            PG8_BAR; PG8_WAIT_L(0); PG8_MMA(0, 1, At, B1); PG8_BAR;
            PG8_LDA(At, 1, 1); PG8_STAGE(PG8_SA(1, 0), a3, voffA);
            PG8_BAR; PG8_WAIT_L(0); PG8_MMA(1, 0, At, B0); PG8_BAR; PG8_SCHED;
            PG8_STAGE(PG8_SB(1, 1), b3 + hstep, voffB);
            PG8_WAIT_V(6); PG8_BAR; PG8_MMA(1, 1, At, B1); PG8_BAR;
        }
        PG8_STAMP();
        if constexpr (!Epi::AFTER_DRAIN) { E(acc, cur, wr, wc, fr, fq); S.done(cur); }
        PG8_STAMP();
        if (!has_next) break;
#pragma unroll
        for (int a = 0; a < 2; ++a)
#pragma unroll
            for (int b = 0; b < 2; ++b)
#pragma unroll
                for (int m = 0; m < 4; ++m)
#pragma unroll
                    for (int n = 0; n < 2; ++n) acc[a][b][m][n] = (f32x4){0.f, 0.f, 0.f, 0.f};
        cur = nxt; cA = nA; cB = nB; ++ui;
    }
    PG8_WAIT_V(0);
    if (wr == 0) PG8_BAR;
    PG8_BAR;
    if constexpr (Epi::AFTER_DRAIN) { E.fused(acc, cur, wr, wc, fr, fq, lds, wid, lane); S.done(cur); }
    PG8_STAMP();
    if (STAMP && wid == 0) { stamps[lane] = lane < nts ? (((unsigned long long)(unsigned)ts_hi << 32) | (unsigned)ts_lo) : 0ull;
        if (lane == 62) stamps[62] = rt_entry; if (lane == 63) stamps[63] = (unsigned long long)wall_clock64(); }
#undef PG8_STAMP
#undef PG8_SA
#undef PG8_SB
#undef PG8_STAGE
#undef PG8_LDA
#undef PG8_LDB
#undef PG8_MMA
#undef PG8_WAIT_V
#undef PG8_WAIT_L
#undef PG8_BAR
#undef PG8_SCHED
}
}

namespace cg = cooperative_groups;
using pg8::bf16_t; using pg8::bf16x8; using pg8::f32x4; using pg8::u32x4; using pg8::Unit; using pg8::cvt_pk_bf16;
typedef float f32x16 __attribute__((ext_vector_type(16)));
#define LAS PG8_LAS

constexpr int MP = 65536, MS = 512, MT = MP + MS;
constexpr int DM = 1024, DFF = 2816, NPROJ = 3072;
constexpr int NCR = 2064, CRP = 2304, KS = 640;
constexpr float EPS = 1e-6f;

constexpr size_t SZ_ACT = (size_t)MT * DM * 2;
constexpr size_t WS_XN = 0;
constexpr size_t WS_HID = WS_XN + SZ_ACT;
constexpr size_t SZ_HID = (size_t)MT * DFF * 2;
constexpr size_t WS_R = WS_HID + SZ_HID;
constexpr size_t WS_H = WS_R + SZ_ACT;
constexpr size_t WS_W1IN = WS_H + SZ_ACT;
constexpr size_t WS_W1OUT = WS_W1IN + (size_t)5632 * 1024 * 2;
constexpr size_t WS_WIN = WS_W1OUT + (size_t)1024 * 2816 * 2;
constexpr size_t WS_WGLU = WS_WIN + (size_t)3072 * 1024 * 2;
constexpr size_t WS_WPOOL = WS_WGLU + (size_t)2048 * 512 * 2;
constexpr size_t WS_WOUT = WS_WPOOL + (size_t)1024 * 512 * 2;
constexpr size_t WS_W2IN = WS_WOUT + (size_t)1024 * 1024 * 2;
constexpr size_t WS_W2OUT = WS_W2IN + (size_t)5632 * 1024 * 2;
constexpr size_t WS_SSMBT = WS_W2OUT + (size_t)1024 * 2816 * 2;
constexpr size_t WS_WEND = WS_SSMBT + (size_t)32 * 512 * KS * 2;
constexpr size_t WS_KLAG = WS_WEND + (size_t)32 * 128 * 512 * 2;
constexpr size_t WS_LP = WS_KLAG + (size_t)32 * 32 * 256 * 4;
constexpr size_t WS_BB = WS_LP + (size_t)32 * 33 * 64 * 8;
constexpr size_t WS_SUMSQ = WS_BB + (size_t)32 * 64 * 16 * 8;
constexpr size_t WS_FLAGS = WS_SUMSQ + (size_t)3 * MT * 4;
constexpr size_t WS_END = WS_FLAGS + 256;
constexpr size_t WS_GATES = WS_HID;
constexpr size_t WS_POOLED = WS_HID + (size_t)MT * 2048 * 2;
constexpr size_t WS_UP = WS_R;
constexpr size_t WS_PM = WS_R;
constexpr size_t WS_E = WS_XN;
constexpr size_t WS_MERGED = WS_XN;
static_assert(WS_POOLED + (size_t)MT * 512 * 2 <= WS_R, "hid region overflow");
constexpr size_t DO_U = 0;
constexpr size_t DO_YG = (size_t)32 * CRP * KS * 2;
static_assert(DO_YG + (size_t)MT * 512 * 2 <= (size_t)MT * DM * 4, "d_out scratch overflow");
constexpr size_t OUT_Y = 0;
constexpr size_t OUT_RE_P = (size_t)MT * DM;
constexpr size_t OUT_IM_P = OUT_RE_P + 16384;
constexpr size_t OUT_POOL_P = OUT_IM_P + 16384;
constexpr size_t OUT_RE_S = OUT_POOL_P + 61440;
constexpr size_t OUT_IM_S = OUT_RE_S + 32768;
constexpr size_t OUT_POOL_S = OUT_IM_S + 32768;

struct Params { const float* in[30]; float* out; unsigned char* ws; };

__device__ __forceinline__ float bflo(unsigned w) { return __uint_as_float(w << 16); }
__device__ __forceinline__ float bfhi(unsigned w) { return __uint_as_float(w & 0xffff0000u); }
__device__ __forceinline__ float fast_sigmoid(float x) { return __builtin_amdgcn_rcpf(1.0f + __expf(-x)); }
__device__ __forceinline__ float wave_sum(float s) {
#pragma unroll
    for (int o = 32; o >= 1; o >>= 1) s += __shfl_xor(s, o);
    return s;
}
__device__ __forceinline__ void unpack8(const u32x4 w, float (&v)[8]) {
    v[0] = bflo(w.x); v[1] = bfhi(w.x); v[2] = bflo(w.y); v[3] = bfhi(w.y); v[4] = bflo(w.z); v[5] = bfhi(w.z); v[6] = bflo(w.w); v[7] = bfhi(w.w);
}
__device__ __forceinline__ u32x4 pack8(const float (&v)[8]) {
    u32x4 w; w.x = cvt_pk_bf16(v[0], v[1]); w.y = cvt_pk_bf16(v[2], v[3]); w.z = cvt_pk_bf16(v[4], v[5]); w.w = cvt_pk_bf16(v[6], v[7]); return w;
}

struct EpiFfnUp {
    static constexpr bool PERM = true, AFTER_DRAIN = false;
    bf16_t* O;
    __device__ __forceinline__ void operator()(const f32x4 (&acc)[2][2][4][2], const Unit& u, int wr, int wc, int fr, int fq) const {
        const int row0 = u.pm * 256 + wr * 64 + fr, col0 = u.pn * 128 + wc * 32 + 8 * fq;
#pragma unroll
        for (int ai = 0; ai < 2; ++ai)
#pragma unroll
            for (int m = 0; m < 4; ++m) {
                float v[8];
#pragma unroll
                for (int n = 0; n < 2; ++n)
#pragma unroll
                    for (int j = 0; j < 4; ++j) { const float a = acc[ai][0][m][n][j], b = acc[ai][1][m][n][j]; v[n * 4 + j] = a * fast_sigmoid(a) * b; }
                *(u32x4*)(O + (size_t)(row0 + ai * 128 + m * 16) * DFF + col0) = pack8(v);
            }
    }
};
struct EpiDown {
    static constexpr bool PERM = true, AFTER_DRAIN = false;
    bf16_t* O; float* sumsq;
    __device__ __forceinline__ void operator()(const f32x4 (&acc)[2][2][4][2], const Unit& u, int wr, int wc, int fr, int fq) const {
        const int row0 = u.pm * 256 + wr * 64 + fr, col0 = u.pn * 256 + wc * 32 + 8 * fq;
#pragma unroll
        for (int ai = 0; ai < 2; ++ai)
#pragma unroll
            for (int m = 0; m < 4; ++m) {
                const int row = row0 + ai * 128 + m * 16; float s = 0.f;
#pragma unroll
                for (int bj = 0; bj < 2; ++bj) {
                    float v[8];
#pragma unroll
                    for (int n = 0; n < 2; ++n)
#pragma unroll
                        for (int j = 0; j < 4; ++j) { const float a = acc[ai][bj][m][n][j]; v[n * 4 + j] = a; s += a * a; }
                    *(u32x4*)(O + (size_t)row * DM + col0 + bj * 128) = pack8(v);
                }
                s += __shfl_xor(s, 16); s += __shfl_xor(s, 32);
                if (fq == 0) atomicAdd(sumsq + row, s);
            }
    }
};
struct EpiInProj {
    static constexpr bool PERM = true, AFTER_DRAIN = false;
    bf16_t* U; bf16_t* UP; bf16_t* GT; const float* bias; float* out;
    __device__ __forceinline__ void operator()(const f32x4 (&acc)[2][2][4][2], const Unit& u, int wr, int wc, int fr, int fq) const {
        const int row0 = u.pm * 256 + wr * 64 + fr;
#pragma unroll
        for (int bj = 0; bj < 2; ++bj) {
            const int col = u.pn * 256 + bj * 128 + wc * 32 + 8 * fq;
            const f32x4 b0 = *(const f32x4*)(bias + col), b1 = *(const f32x4*)(bias + col + 4);
#pragma unroll
            for (int ai = 0; ai < 2; ++ai)
#pragma unroll
                for (int m = 0; m < 4; ++m) {
                    const int row = row0 + ai * 128 + m * 16;
                    float v[8];
#pragma unroll
                    for (int j = 0; j < 4; ++j) { v[j] = acc[ai][bj][m][0][j] + b0[j]; v[4 + j] = acc[ai][bj][m][1][j] + b1[j]; }
                    if (u.pn < 2) {
                        const int g = col >> 4, cc = col & 15, cr = row >> 5, t = row & 31;
                        *(u32x4*)(U + ((size_t)(g * CRP + cr) * KS + t * 16 + cc)) = pack8(v);
                    } else if (u.pn < 4) {
                        const int c = col - 512;
                        *(u32x4*)(UP + (size_t)row * 512 + c) = pack8(v);
                        int hr = -1; size_t ob = 0;
                        if (row < MP) { const int tt = row & 8191; if (tt >= 8177) { hr = tt - 8177; ob = OUT_POOL_P + (size_t)((row >> 13) * 15 + hr) * 512; } }
                        else { const int tt = row & 31; if (tt >= 17) { hr = tt - 17; ob = OUT_POOL_S + (size_t)(((row - MP) >> 5) * 15 + hr) * 512; } }
                        if (hr >= 0) { *(f32x4*)(out + ob + c) = (f32x4){v[0], v[1], v[2], v[3]}; *(f32x4*)(out + ob + c + 4) = (f32x4){v[4], v[5], v[6], v[7]}; }
                    } else {
#pragma unroll
                        for (int j = 0; j < 8; ++j) v[j] = fast_sigmoid(v[j]);
                        *(u32x4*)(GT + (size_t)row * 2048 + (col - 1024)) = pack8(v);
                    }
                }
        }
    }
};
struct EpiSsm {
    static constexpr bool PERM = true, AFTER_DRAIN = false;
    const bf16_t* U; bf16_t* YG; const float* dskip;
    __device__ __forceinline__ void operator()(const f32x4 (&acc)[2][2][4][2], const Unit& u, int wr, int wc, int fr, int fq) const {
        const int g = u.pn >> 1, cr0 = (u.pm - 9 * g) * 256 + wr * 64 + fr;
#pragma unroll
        for (int bj = 0; bj < 2; ++bj) {
            const int col = (u.pn & 1) * 256 + bj * 128 + wc * 32 + 8 * fq, t = col >> 4, cc = col & 15, ch = g * 16 + cc;
            const f32x4 d0 = *(const f32x4*)(dskip + ch), d1 = *(const f32x4*)(dskip + ch + 4);
#pragma unroll
            for (int ai = 0; ai < 2; ++ai)
#pragma unroll
                for (int m = 0; m < 4; ++m) {
                    const int cr = cr0 + ai * 128 + m * 16;
                    if (cr < NCR) {
                        const u32x4 uw = *(const u32x4*)(U + ((size_t)(g * CRP + cr) * KS + col));
                        float uu[8], v[8]; unpack8(uw, uu);
#pragma unroll
                        for (int j = 0; j < 4; ++j) { v[j] = acc[ai][bj][m][0][j] + d0[j] * uu[j]; v[4 + j] = acc[ai][bj][m][1][j] + d1[j] * uu[4 + j]; }
#pragma unroll
                        for (int j = 0; j < 8; ++j) { const float x = v[j]; v[j] = x * fast_sigmoid(1.5957691216f * (x + 0.044715f * x * x * x)); }
                        *(u32x4*)(YG + (size_t)(cr * 32 + t) * 512 + ch) = pack8(v);
                    }
                }
        }
    }
};
struct EpiPool {
    static constexpr bool PERM = true, AFTER_DRAIN = false;
    const bf16_t* GT; bf16_t* PM;
    __device__ __forceinline__ void operator()(const f32x4 (&acc)[2][2][4][2], const Unit& u, int wr, int wc, int fr, int fq) const {
        const int row0 = u.pm * 256 + wr * 64 + fr, col0 = u.pn * 256 + wc * 32 + 8 * fq;
#pragma unroll
        for (int ai = 0; ai < 2; ++ai)
#pragma unroll
            for (int m = 0; m < 4; ++m) {
                const int row = row0 + ai * 128 + m * 16;
#pragma unroll
                for (int bj = 0; bj < 2; ++bj) {
                    const int col = col0 + bj * 128;
                    const u32x4 gw = *(const u32x4*)(GT + (size_t)row * 2048 + 1024 + col);
                    float gg[8], v[8]; unpack8(gw, gg);
#pragma unroll
                    for (int j = 0; j < 4; ++j) { v[j] = acc[ai][bj][m][0][j] * gg[j]; v[4 + j] = acc[ai][bj][m][1][j] * gg[4 + j]; }
                    *(u32x4*)(PM + (size_t)row * DM + col) = pack8(v);
                }
            }
    }
};
struct EpiGlu {
    static constexpr bool PERM = true, AFTER_DRAIN = false;
    const bf16_t* GT; const bf16_t* PM; bf16_t* MG; const float* bias;
    __device__ __forceinline__ void operator()(const f32x4 (&acc)[2][2][4][2], const Unit& u, int wr, int wc, int fr, int fq) const {
        const int row0 = u.pm * 256 + wr * 64 + fr, col = u.pn * 128 + wc * 32 + 8 * fq;
        const f32x4 ba0 = *(const f32x4*)(bias + col), ba1 = *(const f32x4*)(bias + col + 4), bg0 = *(const f32x4*)(bias + 1024 + col), bg1 = *(const f32x4*)(bias + 1024 + col + 4);
#pragma unroll
        for (int ai = 0; ai < 2; ++ai)
#pragma unroll
            for (int m = 0; m < 4; ++m) {
                const int row = row0 + ai * 128 + m * 16;
                const u32x4 gw = *(const u32x4*)(GT + (size_t)row * 2048 + col), pw = *(const u32x4*)(PM + (size_t)row * DM + col);
                float gs[8], pm[8], v[8]; unpack8(gw, gs); unpack8(pw, pm);
#pragma unroll
                for (int j = 0; j < 4; ++j) {
                    v[j] = gs[j] * ((acc[ai][0][m][0][j] + ba0[j]) * fast_sigmoid(acc[ai][1][m][0][j] + bg0[j])) + pm[j];
                    v[4 + j] = gs[4 + j] * ((acc[ai][0][m][1][j] + ba1[j]) * fast_sigmoid(acc[ai][1][m][1][j] + bg1[j])) + pm[4 + j];
                }
                *(u32x4*)(MG + (size_t)row * DM + col) = pack8(v);
            }
    }
};
struct GroupOrder {
    int G, c;
    __device__ __forceinline__ bool next(int i, Unit& u) const { const int L = i * G + c; if (L >= 576) return false; const int g = L / 18, r = L % 18; u.pm = g * 9 + (r >> 1); u.pn = g * 2 + (r & 1); return true; }
    __device__ __forceinline__ void a_ready(const Unit&) const {}
    __device__ __forceinline__ void done(const Unit&) const {}
};

template <int K, int NOUT, int MODE, int HO>
__device__ __forceinline__ void conv_weight(LAS float* tile, const float* __restrict__ W, bf16_t* __restrict__ Wt, const float* __restrict__ rowg, int tid, int bid, int nb) {
    constexpr int TK = K / 64, TN = NOUT / 64;
    for (int t = bid; t < TK * TN; t += nb) {
        const int kt = t % TK, nt = t / TK, k0 = kt * 64, n0 = nt * 64;
        int s0 = n0;
        if (MODE == 1) { const int pn = n0 >> 8, within = n0 & 255, half = within >> 7, i = within & 127; s0 = half * HO + 128 * pn + i; }
        const int kr = tid >> 4, nc = (tid & 15) * 4;
#pragma unroll
        for (int p = 0; p < 2; ++p) {
            const int k = k0 + kr + 32 * p;
            f32x4 v = *(const f32x4*)(W + (size_t)k * NOUT + s0 + nc);
            const float gk = rowg ? rowg[k] : 1.0f;
            LAS float* tp = tile + (kr + 32 * p) * 65 + nc;
            tp[0] = v[0] * gk; tp[1] = v[1] * gk; tp[2] = v[2] * gk; tp[3] = v[3] * gk;
        }
        __syncthreads();
        const int n = tid >> 3, k8 = (tid & 7) * 8;
        float v[8];
#pragma unroll
        for (int i = 0; i < 8; ++i) v[i] = tile[(k8 + i) * 65 + n];
        *(u32x4*)(Wt + (size_t)(n0 + n) * K + k0 + k8) = pack8(v);
        __syncthreads();
    }
}

template <int MODE>
__device__ __forceinline__ void row_phase(const Params& p, const float* __restrict__ sumsq, const float* __restrict__ gain, int gw, int nw, int lane) {
    const bf16_t* R = (const bf16_t*)(p.ws + WS_R); bf16_t* H = (bf16_t*)(p.ws + WS_H); bf16_t* XN = (bf16_t*)(p.ws + WS_XN);
    const float scale = (MODE == 1) ? 1.0f : 0.5f;
    float g[2][8];
#pragma unroll
    for (int i = 0; i < 2; ++i) { const f32x4 a = *(const f32x4*)(gain + i * 512 + lane * 8), b = *(const f32x4*)(gain + i * 512 + lane * 8 + 4);
#pragma unroll
        for (int j = 0; j < 4; ++j) { g[i][j] = a[j] * scale; g[i][4 + j] = b[j] * scale; } }
    for (int row = gw; row < MT; row += nw) {
        const float rstd = rsqrtf(sumsq[row] * (1.0f / 1024.0f) + EPS);
        float h[2][8]; float ss = 0.f; float ssr = 0.f;
#pragma unroll
        for (int i = 0; i < 2; ++i) {
            const size_t off = (size_t)row * DM + i * 512 + lane * 8;
            float r[8]; unpack8(*(const u32x4*)(R + off), r);
#pragma unroll
            for (int j = 0; j < 8; ++j) ssr += r[j] * r[j];
            float b[8];
            if (MODE == 0) { const float* xr = (row < MP) ? (p.in[0] + off) : (p.in[1] + (off - (size_t)MP * DM)); const f32x4 x0 = *(const f32x4*)xr, x1 = *(const f32x4*)(xr + 4);
#pragma unroll
                for (int j = 0; j < 4; ++j) { b[j] = x0[j]; b[4 + j] = x1[j]; } }
            else unpack8(*(const u32x4*)(H + off), b);
#pragma unroll
            for (int j = 0; j < 8; ++j) { h[i][j] = b[j] + r[j] * rstd * g[i][j]; ss += h[i][j] * h[i][j]; }
            if (MODE == 2) { float* o = p.out + OUT_Y + off; *(f32x4*)o = (f32x4){h[i][0], h[i][1], h[i][2], h[i][3]}; *(f32x4*)(o + 4) = (f32x4){h[i][4], h[i][5], h[i][6], h[i][7]}; }
            else *(u32x4*)(H + off) = pack8(h[i]);
        }
        ssr = wave_sum(ssr);
        if (lane == 0 && fabsf(ssr - sumsq[row]) > 0.03f * sumsq[row] + 1e-6f) ((volatile unsigned*)(p.ws + WS_FLAGS))[MODE] = 1u;
        if (MODE != 2) {
            ss = wave_sum(ss);
            const float rs = rsqrtf(ss * (1.0f / 1024.0f) + EPS);
#pragma unroll
            for (int i = 0; i < 2; ++i) { float z[8];
#pragma unroll
                for (int j = 0; j < 8; ++j) z[j] = h[i][j] * rs;
                *(u32x4*)(XN + (size_t)row * DM + i * 512 + lane * 8) = pack8(z); }
        }
    }
}

#define GRID_SYNC() do { __builtin_amdgcn_fence(__ATOMIC_RELEASE, "agent"); asm volatile("s_waitcnt vmcnt(0) lgkmcnt(0)" ::: "memory"); grid.sync(); __builtin_amdgcn_fence(__ATOMIC_ACQUIRE, "agent"); asm volatile("s_waitcnt vmcnt(0)" ::: "memory"); } while (0)
__global__ void __launch_bounds__(512) fwd_megakernel(Params p) {
    extern __shared__ __attribute__((aligned(16))) unsigned char shm[];
    cg::grid_group grid = cg::this_grid();
    LAS unsigned char* lds = (LAS unsigned char*)shm;
    const int tid = threadIdx.x, lane = tid & 63, wid = __builtin_amdgcn_readfirstlane(tid >> 6);
    const int bid = blockIdx.x, nb = gridDim.x, gw = bid * 8 + wid, nw = nb * 8, gt = bid * 512 + tid, nt = nb * 512;
    unsigned char* ws = p.ws; unsigned char* dob = (unsigned char*)p.out;
    bf16_t* XN = (bf16_t*)(ws + WS_XN); bf16_t* HID = (bf16_t*)(ws + WS_HID); bf16_t* R = (bf16_t*)(ws + WS_R);
    bf16_t* GATES = (bf16_t*)(ws + WS_GATES); bf16_t* POOLED = (bf16_t*)(ws + WS_POOLED); bf16_t* UP = (bf16_t*)(ws + WS_UP); bf16_t* PMb = (bf16_t*)(ws + WS_PM);
    bf16_t* MERGED = (bf16_t*)(ws + WS_MERGED); float* Eb = (float*)(ws + WS_E);
    bf16_t* Uq = (bf16_t*)(dob + DO_U); bf16_t* YG = (bf16_t*)(dob + DO_YG);
    bf16_t* W1IN = (bf16_t*)(ws + WS_W1IN); bf16_t* W1OUT = (bf16_t*)(ws + WS_W1OUT); bf16_t* WIN = (bf16_t*)(ws + WS_WIN); bf16_t* WGLU = (bf16_t*)(ws + WS_WGLU);
    bf16_t* WPOOL = (bf16_t*)(ws + WS_WPOOL); bf16_t* WOUT = (bf16_t*)(ws + WS_WOUT); bf16_t* W2IN = (bf16_t*)(ws + WS_W2IN); bf16_t* W2OUT = (bf16_t*)(ws + WS_W2OUT);
    bf16_t* SSMBT = (bf16_t*)(ws + WS_SSMBT); bf16_t* WEND = (bf16_t*)(ws + WS_WEND);
    float* KLAG = (float*)(ws + WS_KLAG); float* LP = (float*)(ws + WS_LP); float* BB = (float*)(ws + WS_BB); float* SUMSQ = (float*)(ws + WS_SUMSQ);

    {
        for (int row = gw; row < MT; row += nw) {
            const float* xr = (row < MP) ? (p.in[0] + (size_t)row * DM) : (p.in[1] + (size_t)(row - MP) * DM);
            f32x4 v[4]; float ss = 0.f;
#pragma unroll
            for (int i = 0; i < 4; ++i) { v[i] = *(const f32x4*)(xr + i * 256 + lane * 4); ss += v[i][0] * v[i][0] + v[i][1] * v[i][1] + v[i][2] * v[i][2] + v[i][3] * v[i][3]; }
            ss = wave_sum(ss);
            const float rs = rsqrtf(ss * (1.0f / 1024.0f) + EPS);
#pragma unroll
            for (int i = 0; i < 4; ++i) { typedef unsigned u32x2 __attribute__((ext_vector_type(2))); u32x2 w; w.x = cvt_pk_bf16(v[i][0] * rs, v[i][1] * rs); w.y = cvt_pk_bf16(v[i][2] * rs, v[i][3] * rs);
                *(u32x2*)(XN + (size_t)row * DM + i * 256 + lane * 4) = w; }
        }
        LAS float* tile = (LAS float*)lds;
        conv_weight<1024, 5632, 1, 2816>(tile, p.in[6], W1IN, p.in[5], tid, bid, nb);
        conv_weight<2816, 1024, 0, 0>(tile, p.in[7], W1OUT, nullptr, tid, bid, nb);
        conv_weight<1024, 3072, 0, 0>(tile, p.in[10], WIN, p.in[9], tid, bid, nb);
        conv_weight<512, 2048, 1, 1024>(tile, p.in[20], WGLU, nullptr, tid, bid, nb);
        conv_weight<1024, 1024, 0, 0>(tile, p.in[24], WOUT, nullptr, tid, bid, nb);
        conv_weight<1024, 5632, 1, 2816>(tile, p.in[27], W2IN, p.in[26], tid, bid, nb);
        conv_weight<2816, 1024, 0, 0>(tile, p.in[28], W2OUT, nullptr, tid, bid, nb);
        for (int i = gt; i < 1024 * 64; i += nt) {
            const int n = i >> 6, k8 = (i & 63) * 8, gi = n >> 8; float v[8];
#pragma unroll
            for (int j = 0; j < 8; ++j) v[j] = 0.f;
            if ((k8 >> 7) == gi) { const float sc = p.in[23][n];
#pragma unroll
                for (int j = 0; j < 8; ++j) v[j] = p.in[22][(size_t)gi * 32768 + (size_t)((k8 & 127) + j) * 256 + (n & 255)] * sc; }
            *(u32x4*)(WPOOL + (size_t)n * 512 + k8) = pack8(v);
        }
        for (int i = gt; i < 32 * 33 * 64; i += nt) {
            const int pp = i & 63, j = (i >> 6) % 33, g = i / (33 * 64);
            const float dt = expf(p.in[14][g]), lr = p.in[12][g * 64 + pp], li = p.in[13][g * 64 + pp];
            const float mag = expf((float)j * lr * dt);
            const double turns = (double)j * ((double)li * (double)dt) * 0.15915494309189533577;
            const float fr = (float)(turns - rint(turns));
            LP[(size_t)i * 2] = mag * __builtin_amdgcn_cosf(fr); LP[(size_t)i * 2 + 1] = mag * __builtin_amdgcn_sinf(fr);
        }
        for (int i = gt; i < 32 * 64; i += nt) {
            const int pp = i & 63, g = i >> 6;
            const float dt = expf(p.in[14][g]), lr = p.in[12][i], li = p.in[13][i];
            const float mag = expf(lr * dt);
            const double turns = ((double)li * (double)dt) * 0.15915494309189533577;
            const float fr = (float)(turns - rint(turns));
            const float abr = mag * __builtin_amdgcn_cosf(fr), abi = mag * __builtin_amdgcn_sinf(fr);
            const float den = lr * lr + li * li, nr = abr - 1.0f;
            const float fre = (nr * lr + abi * li) / den, fim = (abi * lr - nr * li) / den;
#pragma unroll
            for (int c = 0; c < 16; ++c) { const float br = p.in[15][(size_t)i * 16 + c], bi = p.in[16][(size_t)i * 16 + c];
                BB[((size_t)i * 16 + c) * 2] = fre * br - fim * bi; BB[((size_t)i * 16 + c) * 2 + 1] = fre * bi + fim * br; }
            (void)pp;
        }
        for (int i = gt; i < 3 * MT; i += nt) SUMSQ[i] = 0.f;
        if (gt < 64) ((unsigned*)(ws + WS_FLAGS))[gt] = 0u;
    }
    GRID_SYNC();

    { pg8::Gemm g{XN, W1IN, MT, 2 * DFF, DM}; pg8::StaticOrder S; S.init(MT, 2 * DFF, nb, bid); EpiFfnUp E{HID}; pg8::gemm_phase<EpiFfnUp, pg8::StaticOrder, false>(lds, g, S, E, nullptr); }
    {
        for (int i = gt; i < 32 * 32 * 256; i += nt) {
            const int c2 = i & 15, c1 = (i >> 4) & 15, j = (i >> 8) & 31, g = i >> 13; float s = 0.f;
            for (int pp = 0; pp < 64; ++pp) {
                const float cre = p.in[17][(size_t)(g * 16 + c1) * 64 + pp], cim = p.in[18][(size_t)(g * 16 + c1) * 64 + pp];
                const float lre = LP[((size_t)(g * 33 + j) * 64 + pp) * 2], lim = LP[((size_t)(g * 33 + j) * 64 + pp) * 2 + 1];
                const float bre = BB[((size_t)(g * 64 + pp) * 16 + c2) * 2], bim = BB[((size_t)(g * 64 + pp) * 16 + c2) * 2 + 1];
                const float tr = lre * bre - lim * bim, ti = lre * bim + lim * bre;
                s += cre * tr - cim * ti;
            }
            KLAG[i] = s;
        }
        for (int i = gt; i < 32 * 128 * 512; i += nt) {
            const int k = i & 511, pq = (i >> 9) & 127, g = i >> 16, t1 = k >> 4, c2 = k & 15, pp = pq & 63;
            const float lre = LP[((size_t)(g * 33 + 31 - t1) * 64 + pp) * 2], lim = LP[((size_t)(g * 33 + 31 - t1) * 64 + pp) * 2 + 1];
            const float bre = BB[((size_t)(g * 64 + pp) * 16 + c2) * 2], bim = BB[((size_t)(g * 64 + pp) * 16 + c2) * 2 + 1];
            const float v = (pq < 64) ? (lre * bre - lim * bim) : (lre * bim + lim * bre);
            WEND[i] = (bf16_t)(cvt_pk_bf16(v, 0.f) & 0xffffu);
        }
        for (int i = gt; i < 32 * 512 * 128; i += nt) {
            const int pq = i & 127, n = (i >> 7) & 511, g = i >> 16, t = n >> 4, c1 = n & 15, pp = pq & 63;
            const float cre = p.in[17][(size_t)(g * 16 + c1) * 64 + pp], cim = p.in[18][(size_t)(g * 16 + c1) * 64 + pp];
            const float lre = LP[((size_t)(g * 33 + t + 1) * 64 + pp) * 2], lim = LP[((size_t)(g * 33 + t + 1) * 64 + pp) * 2 + 1];
            const float v = (pq < 64) ? (cre * lre - cim * lim) : -(cre * lim + cim * lre);
            SSMBT[((size_t)(g * 512 + n)) * KS + 512 + pq] = (bf16_t)(cvt_pk_bf16(v, 0.f) & 0xffffu);
        }
    }
    GRID_SYNC();

    { pg8::Gemm g{HID, W1OUT, MT, DM, DFF}; pg8::StaticOrder S; S.init(MT, DM, nb, bid); EpiDown E{R, SUMSQ}; pg8::gemm_phase<EpiDown, pg8::StaticOrder, false>(lds, g, S, E, nullptr); }
    for (int i = gt; i < 32 * 512 * 64; i += nt) {
        const int k8 = (i & 63) * 8, n = (i >> 6) & 511, g = i >> 15, t = n >> 4, c1 = n & 15, t1 = k8 >> 4, c20 = k8 & 15; float v[8];
#pragma unroll
        for (int j = 0; j < 8; ++j) v[j] = (t1 <= t) ? KLAG[(size_t)((g * 32 + (t - t1)) * 16 + c1) * 16 + c20 + j] : 0.f;
        *(u32x4*)(SSMBT + (size_t)(g * 512 + n) * KS + k8) = pack8(v);
    }
    GRID_SYNC();

    row_phase<0>(p, SUMSQ, p.in[8], gw, nw, lane);
    GRID_SYNC();

    { pg8::Gemm g{XN, WIN, MT, NPROJ, DM}; pg8::StaticOrder S; S.init(MT, NPROJ, nb, bid); EpiInProj E{Uq, UP, GATES, p.in[11], p.out}; pg8::gemm_phase<EpiInProj, pg8::StaticOrder, false>(lds, g, S, E, nullptr); }
    GRID_SYNC();

    {
        for (int task = gw; task < 32 * 65; task += nw) {
            const int g = task / 65, cr0 = (task % 65) * 32;
            f32x16 acc[4];
#pragma unroll
            for (int q = 0; q < 4; ++q)
#pragma unroll
                for (int j = 0; j < 16; ++j) acc[q][j] = 0.f;
            const bf16_t* Ab = Uq + ((size_t)(g * CRP + cr0 + (lane & 31)) * KS + 8 * (lane >> 5));
            const bf16_t* Bb = WEND + ((size_t)(g * 128 + (lane & 31)) * 512 + 8 * (lane >> 5));
#pragma unroll 4
            for (int k0 = 0; k0 < 512; k0 += 16) {
                const bf16x8 a = *(const bf16x8*)(Ab + k0);
#pragma unroll
                for (int q = 0; q < 4; ++q) { const bf16x8 b = *(const bf16x8*)(Bb + (size_t)q * 32 * 512 + k0); acc[q] = __builtin_amdgcn_mfma_f32_32x32x16_bf16(a, b, acc[q], 0, 0, 0); }
            }
#pragma unroll
            for (int q = 0; q < 4; ++q)
#pragma unroll
                for (int j = 0; j < 16; ++j) { const int row = (j & 3) + 8 * (j >> 2) + 4 * (lane >> 5); Eb[(size_t)(g * CRP + cr0 + row) * 128 + q * 32 + (lane & 31)] = acc[q][j]; }
        }
        for (int i = gt; i < NCR * 64; i += nt) {
            const int oct = i & 63, cr = i >> 6, gi = oct >> 4, w = 2 << gi, r0 = cr * 32;
            const bool smp = cr >= 2048; const int pos0 = smp ? 2048 : (cr & 255) * 32;
            const float* cache = p.in[4] + (size_t)(cr - 2048) * 15 * 512 + oct * 8;
            float S[8];
#pragma unroll
            for (int j = 0; j < 8; ++j) S[j] = 0.f;
            for (int tt = 1 - w; tt < 0; ++tt) {
                float v[8];
                if (smp) { const f32x4 a = *(const f32x4*)(cache + (size_t)(15 + tt) * 512), b = *(const f32x4*)(cache + (size_t)(15 + tt) * 512 + 4);
#pragma unroll
                    for (int j = 0; j < 4; ++j) { v[j] = a[j]; v[4 + j] = b[j]; } }
                else if (pos0 + tt >= 0) unpack8(*(const u32x4*)(UP + (size_t)(r0 + tt) * 512 + oct * 8), v);
                else {
#pragma unroll
                    for (int j = 0; j < 8; ++j) v[j] = 0.f; }
#pragma unroll
                for (int j = 0; j < 8; ++j) S[j] += v[j];
            }
            for (int t = 0; t < 32; ++t) {
                float cur[8]; unpack8(*(const u32x4*)(UP + (size_t)(r0 + t) * 512 + oct * 8), cur);
                if (t > 0) {
                    const int tt = t - w; float v[8];
                    if (tt >= 0) unpack8(*(const u32x4*)(UP + (size_t)(r0 + tt) * 512 + oct * 8), v);
                    else if (smp) { const f32x4 a = *(const f32x4*)(cache + (size_t)(15 + tt) * 512), b = *(const f32x4*)(cache + (size_t)(15 + tt) * 512 + 4);
#pragma unroll
                        for (int j = 0; j < 4; ++j) { v[j] = a[j]; v[4 + j] = b[j]; } }
                    else if (pos0 + tt >= 0) unpack8(*(const u32x4*)(UP + (size_t)(r0 + tt) * 512 + oct * 8), v);
                    else {
#pragma unroll
                        for (int j = 0; j < 8; ++j) v[j] = 0.f; }
#pragma unroll
                    for (int j = 0; j < 8; ++j) S[j] -= v[j];
                }
                const int pos = pos0 + t; const float inv = 1.0f / (float)((pos + 1 < w) ? (pos + 1) : w);
                float o[8];
#pragma unroll
                for (int j = 0; j < 8; ++j) { S[j] += cur[j]; o[j] = S[j] * inv - cur[j]; }
                *(u32x4*)(POOLED + (size_t)(r0 + t) * 512 + oct * 8) = pack8(o);
            }
        }
    }
    GRID_SYNC();

    {
        for (int task = gw; task < 8 * 32 + 16 * 32; task += nw) {
            const bool smp = task >= 256; const int tk = smp ? task - 256 : task, b = tk >> 5, g = tk & 31;
            const float l32r = LP[((size_t)(g * 33 + 32) * 64 + lane) * 2], l32i = LP[((size_t)(g * 33 + 32) * 64 + lane) * 2 + 1];
            float sr = 0.f, si = 0.f; int cr = b * 256, nk = 256;
            if (smp) { sr = p.in[2][(size_t)(b * 32 + g) * 64 + lane]; si = p.in[3][(size_t)(b * 32 + g) * 64 + lane]; cr = 2048 + b; nk = 1; }
            for (int k = 0; k < nk; ++k, ++cr) {
                const size_t base = (size_t)(g * CRP + cr);
                Uq[base * KS + 512 + lane] = (bf16_t)(cvt_pk_bf16(sr, 0.f) & 0xffffu);
                Uq[base * KS + 576 + lane] = (bf16_t)(cvt_pk_bf16(si, 0.f) & 0xffffu);
                const float er = Eb[base * 128 + lane], ei = Eb[base * 128 + 64 + lane];
                const float nr = l32r * sr - l32i * si + er, ni = l32r * si + l32i * sr + ei;
                sr = nr; si = ni;
            }
            const size_t o = (size_t)(b * 32 + g) * 64 + lane;
            if (smp) { p.out[OUT_RE_S + o] = sr; p.out[OUT_IM_S + o] = si; } else { p.out[OUT_RE_P + o] = sr; p.out[OUT_IM_P + o] = si; }
        }
    }
    GRID_SYNC();

    { pg8::Gemm g{Uq, SSMBT, 32 * CRP, 32 * 512, KS}; GroupOrder S{nb, bid}; EpiSsm E{Uq, YG, p.in[19]}; pg8::gemm_phase<EpiSsm, GroupOrder, false>(lds, g, S, E, nullptr); }
    { pg8::Gemm g{POOLED, WPOOL, MT, DM, 512}; pg8::StaticOrder S; S.init(MT, DM, nb, bid); EpiPool E{GATES, PMb}; pg8::gemm_phase<EpiPool, pg8::StaticOrder, false>(lds, g, S, E, nullptr); }
    GRID_SYNC();

    { pg8::Gemm g{YG, WGLU, MT, 2 * DM, 512}; pg8::StaticOrder S; S.init(MT, 2 * DM, nb, bid); EpiGlu E{GATES, PMb, MERGED, p.in[21]}; pg8::gemm_phase<EpiGlu, pg8::StaticOrder, false>(lds, g, S, E, nullptr); }
    GRID_SYNC();

    { pg8::Gemm g{MERGED, WOUT, MT, DM, DM}; pg8::StaticOrder S; S.init(MT, DM, nb, bid); EpiDown E{R, SUMSQ + MT}; pg8::gemm_phase<EpiDown, pg8::StaticOrder, false>(lds, g, S, E, nullptr); }
    GRID_SYNC();

    row_phase<1>(p, SUMSQ + MT, p.in[25], gw, nw, lane);
    GRID_SYNC();

    { pg8::Gemm g{XN, W2IN, MT, 2 * DFF, DM}; pg8::StaticOrder S; S.init(MT, 2 * DFF, nb, bid); EpiFfnUp E{HID}; pg8::gemm_phase<EpiFfnUp, pg8::StaticOrder, false>(lds, g, S, E, nullptr); }
    GRID_SYNC();

    { pg8::Gemm g{HID, W2OUT, MT, DM, DFF}; pg8::StaticOrder S; S.init(MT, DM, nb, bid); EpiDown E{R, SUMSQ + 2 * MT}; pg8::gemm_phase<EpiDown, pg8::StaticOrder, false>(lds, g, S, E, nullptr); }
    GRID_SYNC();

    row_phase<2>(p, SUMSQ + 2 * MT, p.in[29], gw, nw, lane);
}

extern "C" void kernel_launch(void* const* d_in, const int* in_sizes, int n_in, void* d_out, int out_size, void* d_ws, size_t ws_size, hipStream_t stream) {
    constexpr int LDS_BYTES = pg8::STAGE_BYTES;
    static int grid = 0;
    if (grid == 0) {
        if (n_in != 30 || ws_size < WS_END) { fprintf(stderr, "kernel_launch: expected 30 inputs and >= %zu bytes of workspace; got %d, %zu\n", (size_t)WS_END, n_in, ws_size); grid = -1; return; }
        int dev = 0, cus = 0, per_cu = 0;
        hipGetDevice(&dev); hipDeviceGetAttribute(&cus, hipDeviceAttributeMultiprocessorCount, dev);
        if (hipFuncSetAttribute((const void*)fwd_megakernel, hipFuncAttributeMaxDynamicSharedMemorySize, LDS_BYTES) != hipSuccess) { fprintf(stderr, "kernel_launch: hipFuncSetAttribute failed\n"); grid = -1; return; }
        if (hipOccupancyMaxActiveBlocksPerMultiprocessor(&per_cu, (const void*)fwd_megakernel, 512, LDS_BYTES) != hipSuccess || per_cu < 1) { fprintf(stderr, "kernel_launch: occupancy query says %d blocks per CU\n", per_cu); (void)hipGetLastError(); per_cu = 1; }
        grid = cus;
    }
    if (grid < 0) return;
    Params p{};
    for (int i = 0; i < 30; ++i) p.in[i] = (const float*)d_in[i];
    p.out = (float*)d_out; p.ws = (unsigned char*)d_ws;
    void* args[] = {&p};
    hipError_t e = hipLaunchCooperativeKernel((const void*)fwd_megakernel, dim3(grid), dim3(512), args, LDS_BYTES, stream);
    if (e != hipSuccess) fprintf(stderr, "kernel_launch: cooperative launch failed: %s (grid %d)\n", hipGetErrorString(e), grid);
}
```

```cpp
#include <hip/hip_runtime.h>
#include <hip/hip_cooperative_groups.h>
#include <cstdio>
namespace pg8 {
#define PG8_LAS __attribute__((address_space(3)))
typedef unsigned short bf16_t;
typedef short bf16x8 __attribute__((ext_vector_type(8)));
typedef float f32x4 __attribute__((ext_vector_type(4)));
typedef unsigned u32x4 __attribute__((ext_vector_type(4)));
constexpr int BM = 256, BK = 64, HALF = 128, HTB = HALF * BK * 2  , STAGE_BYTES = 8 * HTB, NXCD = 8, WGM = 8;

__host__ __device__ __forceinline__ int lds_byte(int r, int c) { const int st = (r >> 4) * 2 + (c >> 5), rr = r & 15, cc = c & 31, ob = rr * 64 + cc * 2; return st * 1024 + (ob ^ (((ob >> 9) & 1) << 5)); }
__host__ __device__ __forceinline__ void stage_rc(int b, int& R, int& C) { const int st = b / 1024, sb = b % 1024, swz = sb ^ (((sb >> 9) & 1) << 5); R = (st >> 1) * 16 + swz / 64; C = (st & 1) * 32 + (swz % 64) / 2; }
__host__ __device__ __forceinline__ int perm32(int rho) { const int n = rho >> 4, i = rho & 15; return 8 * (i >> 2) + 4 * n + (i & 3); }

struct Unit { int pm, pn; };
struct Gemm { const bf16_t* A; const bf16_t* Bt; int M, N, K; };

struct StaticOrder {
    int nM, nN, nwg, G, c;
    __host__ __device__ void init(int M, int N, int G_, int c_) { nM = M / BM; nN = N / BM; nwg = nM * nN; G = G_; c = c_; }
    __host__ __device__ bool next(int i, Unit& u) const {
        const long L = (long)i * G + c; if (L >= nwg) return false;
        int wgid = (int)L; { const int q = nwg / NXCD, r = nwg % NXCD, xcd = wgid % NXCD, off = wgid / NXCD; wgid = (xcd < r ? xcd * (q + 1) : r * (q + 1) + (xcd - r) * q) + off; }
        const int nig = WGM * nN, gid = wgid / nig, fm = gid * WGM, gsz = (nM - fm) < WGM ? (nM - fm) : WGM;
        u.pm = fm + ((wgid % nig) % gsz); u.pn = (wgid % nig) / gsz; return true;
    }
    __device__ __forceinline__ void a_ready(const Unit&) const {}
    __device__ __forceinline__ void done(const Unit&) const {}
};
typedef float f32x2c __attribute__((ext_vector_type(2))); typedef __bf16 bf16x2c __attribute__((ext_vector_type(2)));
__device__ __forceinline__ unsigned cvt_pk_bf16(float lo, float hi) { const f32x2c f = {lo, hi}; const bf16x2c b = __builtin_convertvector(f, bf16x2c); return __builtin_bit_cast(unsigned, b); }
typedef float f32x2 __attribute__((ext_vector_type(2)));
template <class Epi, class Sched, bool STAMP = false>
__device__ __forceinline__ void gemm_phase(PG8_LAS unsigned char* lds, const Gemm g, const Sched& S, const Epi& E, unsigned long long* stamps) {
    int tid_; asm volatile("v_mov_b32 %0, %1" : "=v"(tid_) : "v"((int)threadIdx.x)); const int tid = tid_, wid = __builtin_amdgcn_readfirstlane(tid >> 6), lane = tid & 63, wr = wid >> 2, wc = wid & 3, fr = lane & 15, fq = lane >> 4;
    const int K = g.K, nt = K / BK;
    int ts_lo = 0, ts_hi = 0, nts = 0; const unsigned long long rt_entry = STAMP ? (unsigned long long)wall_clock64() : 0ull;
#define PG8_STAMP() do { if (STAMP && wid == 0 && nts < 64) { const unsigned long long _c = (unsigned long long)clock64(); \
        ts_lo = (lane == nts) ? (int)(unsigned)_c : ts_lo; ts_hi = (lane == nts) ? (int)(unsigned)(_c >> 32) : ts_hi; ++nts; } } while (0)
    PG8_STAMP();
    unsigned voffA[2], voffB[2];
#pragma unroll
    for (int i = 0; i < 2; ++i) { int R, C; stage_rc(tid * 16 + i * 8192, R, C); const int Rb = Epi::PERM ? ((R & ~31) + perm32(R & 31)) : R;
        voffA[i] = (unsigned)(R * K + C) * 2u; voffB[i] = (unsigned)(Rb * K + C) * 2u; }
    const size_t kstep = (size_t)(BK * 2);
    const size_t hstep = (size_t)HALF * K * 2;
    const size_t tstep = 2 * hstep;
    const unsigned ldsw = (unsigned)wid * 1024u;
    const int aoff = lds_byte(wr * 64 + fr, fq * 8), boff = lds_byte(wc * 32 + fr, fq * 8);
#define PG8_SA(b, h) (((b) * 2 + (h)) * HTB)
#define PG8_SB(b, h) ((4 + (b) * 2 + (h)) * HTB)
#define PG8_STAGE(bufoff, gbase, voff) do { _Pragma("unroll") for (int _i = 0; _i < 2; ++_i) \
        __builtin_amdgcn_global_load_lds((const unsigned*)((const char*)(gbase) + (voff)[_i]), (PG8_LAS unsigned*)(lds + (bufoff) + ldsw + _i * 8192), 16, 0, 0); } while (0)
#define PG8_LDA(dst, b, h) do { _Pragma("unroll") for (int m = 0; m < 4; ++m) _Pragma("unroll") for (int k = 0; k < 2; ++k) dst[m][k] = *(const PG8_LAS bf16x8*)(lds + PG8_SA(b, h) + aoff + m * 2048 + k * 1024); } while (0)
#define PG8_LDB(dst, b, h) do { _Pragma("unroll") for (int n = 0; n < 2; ++n) _Pragma("unroll") for (int k = 0; k < 2; ++k) dst[n][k] = *(const PG8_LAS bf16x8*)(lds + PG8_SB(b, h) + boff + n * 2048 + k * 1024); } while (0)
#define PG8_MMA(ai, bj, At, Bt) do { __builtin_amdgcn_s_setprio(1); _Pragma("unroll") for (int m = 0; m < 4; ++m) _Pragma("unroll") for (int n = 0; n < 2; ++n) _Pragma("unroll") for (int k = 0; k < 2; ++k) \
        acc[ai][bj][m][n] = __builtin_amdgcn_mfma_f32_16x16x32_bf16(Bt[n][k], At[m][k], acc[ai][bj][m][n], 0, 0, 0); __builtin_amdgcn_s_setprio(0); } while (0)
#define PG8_WAIT_V(n) asm volatile("s_waitcnt vmcnt(" #n ")" ::: "memory")
#define PG8_WAIT_L(n) asm volatile("s_waitcnt lgkmcnt(" #n ")" ::: "memory")
#define PG8_BAR __builtin_amdgcn_s_barrier()
#define PG8_SCHED __builtin_amdgcn_sched_barrier(0)
    Unit cur, nxt; int ui = 0;
    if (!S.next(0, cur)) return;
    f32x4 acc[2][2][4][2];
#pragma unroll
    for (int a = 0; a < 2; ++a)
#pragma unroll
        for (int b = 0; b < 2; ++b)
#pragma unroll
            for (int m = 0; m < 4; ++m)
#pragma unroll
                for (int n = 0; n < 2; ++n) acc[a][b][m][n] = (f32x4){0.f, 0.f, 0.f, 0.f};
    bf16x8 At[4][2], B0[2][2], B1[2][2];
    const char* cA = (const char*)g.A + (size_t)cur.pm * tstep; const char* cB = (const char*)g.Bt + (size_t)cur.pn * tstep;
    S.a_ready(cur);
    PG8_STAGE(PG8_SB(0, 0), cB, voffB); PG8_STAGE(PG8_SA(0, 0), cA, voffA); PG8_STAGE(PG8_SB(0, 1), cB + hstep, voffB); PG8_STAGE(PG8_SA(0, 1), cA + hstep, voffA);
    if (wr == 1) PG8_BAR;
    PG8_WAIT_V(4); PG8_BAR;
    PG8_STAGE(PG8_SB(1, 0), cB + kstep, voffB); PG8_STAGE(PG8_SA(1, 0), cA + kstep, voffA); PG8_STAGE(PG8_SB(1, 1), cB + hstep + kstep, voffB);
    PG8_WAIT_V(6); PG8_BAR;
    PG8_STAMP();
    for (;;) {
        const bool has_next = S.next(ui + 1, nxt);
        const char* nA = has_next ? (const char*)g.A + (size_t)nxt.pm * tstep : cA; const char* nB = has_next ? (const char*)g.Bt + (size_t)nxt.pn * tstep : cB;
        for (int t = 0; t < nt; t += 2) {
            const bool last = (t == nt - 2);
            const char* a1 = cA + (size_t)(t + 1) * kstep;
            const char* a2 = last ? nA : cA + (size_t)(t + 2) * kstep; const char* b2 = last ? nB : cB + (size_t)(t + 2) * kstep;
            const char* a3 = a2 + kstep; const char* b3 = b2 + kstep;
            if (last && has_next) S.a_ready(nxt);
            PG8_LDB(B0, 0, 0); PG8_SCHED; PG8_LDA(At, 0, 0); PG8_STAGE(PG8_SA(1, 1), a1 + hstep, voffA);
            PG8_WAIT_L(8); PG8_BAR; PG8_WAIT_L(0); PG8_MMA(0, 0, At, B0); PG8_BAR; PG8_SCHED;
            PG8_LDB(B1, 0, 1); PG8_STAGE(PG8_SB(0, 0), b2, voffB);
            PG8_BAR; PG8_WAIT_L(0); PG8_MMA(0, 1, At, B1); PG8_BAR;
            PG8_LDA(At, 0, 1); PG8_STAGE(PG8_SA(0, 0), a2, voffA);
            PG8_BAR; PG8_WAIT_L(0); PG8_MMA(1, 0, At, B0); PG8_BAR; PG8_SCHED;
            PG8_STAGE(PG8_SB(0, 1), b2 + hstep, voffB);
            PG8_WAIT_V(6); PG8_BAR; PG8_MMA(1, 1, At, B1); PG8_BAR;
            PG8_LDB(B0, 1, 0); PG8_SCHED; PG8_LDA(At, 1, 0); PG8_STAGE(PG8_SA(0, 1), a2 + hstep, voffA);
            PG8_WAIT_L(8); PG8_BAR; PG8_WAIT_L(0); PG8_MMA(0, 0, At, B0); PG8_BAR; PG8_SCHED;
            PG8_LDB(B1, 1, 1); PG8_STAGE(PG8_SB(1, 0), b3, voffB);
            PG8_BAR; PG8_WAIT_L(0); PG8_MMA(0, 1, At, B1); PG8_BAR;
            PG8_LDA(At, 1, 1); PG8_STAGE(PG8_SA(1, 0), a3, voffA);
            PG8_BAR; PG8_WAIT_L(0); PG8_MMA(1, 0, At, B0); PG8_BAR; PG8_SCHED;
            PG8_STAGE(PG8_SB(1, 1), b3 + hstep, voffB);
            PG8_WAIT_V(6); PG8_BAR; PG8_MMA(1, 1, At, B1); PG8_BAR;
        }
        PG8_STAMP();
        if constexpr (!Epi::AFTER_DRAIN) { E(acc, cur, wr, wc, fr, fq); S.done(cur); }
        PG8_STAMP();
        if (!has_next) break;
#pragma unroll
        for (int a = 0; a < 2; ++a)
#pragma unroll
            for (int b = 0; b < 2; ++b)
#pragma unroll
                for (int m = 0; m < 4; ++m)
#pragma unroll
                    for (int n = 0; n < 2; ++n) acc[a][b][m][n] = (f32x4){0.f, 0.f, 0.f, 0.f};
        cur = nxt; cA = nA; cB = nB; ++ui;
    }
    PG8_WAIT_V(0);
    if (wr == 0) PG8_BAR;
    PG8_BAR;
    if constexpr (Epi::AFTER_DRAIN) { E.fused(acc, cur, wr, wc, fr, fq, lds, wid, lane); S.done(cur); }
    PG8_STAMP();
    if (STAMP && wid == 0) { stamps[lane] = lane < nts ? (((unsigned long long)(unsigned)ts_hi << 32) | (unsigned)ts_lo) : 0ull;
        if (lane == 62) stamps[62] = rt_entry; if (lane == 63) stamps[63] = (unsigned long long)wall_clock64(); }
#undef PG8_STAMP
#undef PG8_SA
#undef PG8_SB
#undef PG8_STAGE
#undef PG8_LDA
#undef PG8_LDB
#undef PG8_MMA
#undef PG8_WAIT_V
#undef PG8_WAIT_L
#undef PG8_BAR
#undef PG8_SCHED
}
}

namespace cg = cooperative_groups;
using pg8::bf16_t; using pg8::bf16x8; using pg8::f32x4; using pg8::u32x4; using pg8::Unit; using pg8::cvt_pk_bf16;
typedef float f32x16 __attribute__((ext_vector_type(16)));
#define LAS PG8_LAS

constexpr int MP = 65536, MS = 512, MT = MP + MS;
constexpr int DM = 1024, DFF = 2816, NPROJ = 3072;
constexpr int NCR = 2064, CRP = 2304, KS = 640;
constexpr float EPS = 1e-6f;

constexpr size_t SZ_ACT = (size_t)MT * DM * 2;
constexpr size_t WS_XN = 0;
constexpr size_t WS_HID = WS_XN + SZ_ACT;
constexpr size_t SZ_HID = (size_t)MT * DFF * 2;
constexpr size_t WS_R = WS_HID + SZ_HID;
constexpr size_t WS_H = WS_R + SZ_ACT;
constexpr size_t WS_W1IN = WS_H + SZ_ACT;
constexpr size_t WS_W1OUT = WS_W1IN + (size_t)5632 * 1024 * 2;
constexpr size_t WS_WIN = WS_W1OUT + (size_t)1024 * 2816 * 2;
constexpr size_t WS_WGLU = WS_WIN + (size_t)3072 * 1024 * 2;
constexpr size_t WS_WPOOL = WS_WGLU + (size_t)2048 * 512 * 2;
constexpr size_t WS_WOUT = WS_WPOOL + (size_t)1024 * 512 * 2;
constexpr size_t WS_W2IN = WS_WOUT + (size_t)1024 * 1024 * 2;
constexpr size_t WS_W2OUT = WS_W2IN + (size_t)5632 * 1024 * 2;
constexpr size_t WS_SSMBT = WS_W2OUT + (size_t)1024 * 2816 * 2;
constexpr size_t WS_WEND = WS_SSMBT + (size_t)32 * 512 * KS * 2;
constexpr size_t WS_KLAG = WS_WEND + (size_t)32 * 128 * 512 * 2;
constexpr size_t WS_LP = WS_KLAG + (size_t)32 * 32 * 256 * 4;
constexpr size_t WS_BB = WS_LP + (size_t)32 * 33 * 64 * 8;
constexpr size_t WS_SUMSQ = WS_BB + (size_t)32 * 64 * 16 * 8;
constexpr size_t WS_FLAGS = WS_SUMSQ + (size_t)3 * MT * 4;
constexpr size_t WS_BAR = WS_FLAGS + 256;
constexpr size_t WS_BAR_BYTES = 24 * 256;
constexpr size_t WS_RSTD = WS_BAR + WS_BAR_BYTES;
constexpr size_t WS_UPD = (WS_RSTD + (size_t)3 * MT * 4 + 255) & ~(size_t)255;
constexpr size_t WS_END = WS_UPD + (size_t)MT * 512 * 2;
constexpr size_t WS_GATES = WS_HID;
constexpr size_t WS_POOLED = WS_HID + (size_t)MT * 2048 * 2;
constexpr size_t WS_UP = WS_UPD;
constexpr size_t WS_PM = WS_R;
constexpr size_t WS_E = WS_XN;
constexpr size_t WS_MERGED = WS_XN;
static_assert(WS_POOLED + (size_t)MT * 512 * 2 <= WS_R, "hid region overflow");
constexpr size_t DO_U = 0;
constexpr size_t DO_YG = (size_t)32 * CRP * KS * 2;
static_assert(DO_YG + (size_t)MT * 512 * 2 <= (size_t)MT * DM * 4, "d_out scratch overflow");
constexpr size_t OUT_Y = 0;
constexpr size_t OUT_RE_P = (size_t)MT * DM;
constexpr size_t OUT_IM_P = OUT_RE_P + 16384;
constexpr size_t OUT_POOL_P = OUT_IM_P + 16384;
constexpr size_t OUT_RE_S = OUT_POOL_P + 61440;
constexpr size_t OUT_IM_S = OUT_RE_S + 32768;
constexpr size_t OUT_POOL_S = OUT_IM_S + 32768;

struct Params { const float* in[30]; float* out; unsigned char* ws; };

__device__ __forceinline__ float bflo(unsigned w) { return __uint_as_float(w << 16); }
__device__ __forceinline__ float bfhi(unsigned w) { return __uint_as_float(w & 0xffff0000u); }
__device__ __forceinline__ float fast_sigmoid(float x) { return __builtin_amdgcn_rcpf(1.0f + __expf(-x)); }
__device__ __forceinline__ float wave_sum(float s) {
#pragma unroll
    for (int o = 32; o >= 1; o >>= 1) s += __shfl_xor(s, o);
    return s;
}
__device__ __forceinline__ void unpack8(const u32x4 w, float (&v)[8]) {
    v[0] = bflo(w.x); v[1] = bfhi(w.x); v[2] = bflo(w.y); v[3] = bfhi(w.y); v[4] = bflo(w.z); v[5] = bfhi(w.z); v[6] = bflo(w.w); v[7] = bfhi(w.w);
}
__device__ __forceinline__ u32x4 pack8(const float (&v)[8]) {
    u32x4 w; w.x = cvt_pk_bf16(v[0], v[1]); w.y = cvt_pk_bf16(v[2], v[3]); w.z = cvt_pk_bf16(v[4], v[5]); w.w = cvt_pk_bf16(v[6], v[7]); return w;
}

struct EpiFfnUp {
    static constexpr bool PERM = true, AFTER_DRAIN = false;
    bf16_t* O;
    __device__ __forceinline__ void operator()(const f32x4 (&acc)[2][2][4][2], const Unit& u, int wr, int wc, int fr, int fq) const {
        const int row0 = u.pm * 256 + wr * 64 + fr, col0 = u.pn * 128 + wc * 32 + 8 * fq;
#pragma unroll
        for (int ai = 0; ai < 2; ++ai)
#pragma unroll
            for (int m = 0; m < 4; ++m) {
                float v[8];
#pragma unroll
                for (int n = 0; n < 2; ++n)
#pragma unroll
                    for (int j = 0; j < 4; ++j) { const float a = acc[ai][0][m][n][j], b = acc[ai][1][m][n][j]; v[n * 4 + j] = a * fast_sigmoid(a) * b; }
                *(u32x4*)(O + (size_t)(row0 + ai * 128 + m * 16) * DFF + col0) = pack8(v);
            }
    }
};
struct EpiDown {
    static constexpr bool PERM = true, AFTER_DRAIN = false;
    bf16_t* O; float* sumsq;
    __device__ __forceinline__ void operator()(const f32x4 (&acc)[2][2][4][2], const Unit& u, int wr, int wc, int fr, int fq) const {
        const int row0 = u.pm * 256 + wr * 64 + fr, col0 = u.pn * 256 + wc * 32 + 8 * fq;
#pragma unroll
        for (int ai = 0; ai < 2; ++ai)
#pragma unroll
            for (int m = 0; m < 4; ++m) {
                const int row = row0 + ai * 128 + m * 16; float s = 0.f;
#pragma unroll
                for (int bj = 0; bj < 2; ++bj) {
                    float v[8];
#pragma unroll
                    for (int n = 0; n < 2; ++n)
#pragma unroll
                        for (int j = 0; j < 4; ++j) { const float a = acc[ai][bj][m][n][j]; v[n * 4 + j] = a; s += a * a; }
                    *(u32x4*)(O + (size_t)row * DM + col0 + bj * 128) = pack8(v);
                }
                s += __shfl_xor(s, 16); s += __shfl_xor(s, 32);
                if (fq == 0) atomicAdd(sumsq + row, s);
            }
    }
};
struct EpiInProj {
    static constexpr bool PERM = true, AFTER_DRAIN = false;
    bf16_t* U; bf16_t* UP; bf16_t* GT; const float* bias; float* out; const float* rs;
    __device__ __forceinline__ void operator()(const f32x4 (&acc)[2][2][4][2], const Unit& u, int wr, int wc, int fr, int fq) const {
        const int row0 = u.pm * 256 + wr * 64 + fr;
#pragma unroll
        for (int bj = 0; bj < 2; ++bj) {
            const int col = u.pn * 256 + bj * 128 + wc * 32 + 8 * fq;
            const f32x4 b0 = *(const f32x4*)(bias + col), b1 = *(const f32x4*)(bias + col + 4);
#pragma unroll
            for (int ai = 0; ai < 2; ++ai)
#pragma unroll
                for (int m = 0; m < 4; ++m) {
                    const int row = row0 + ai * 128 + m * 16; const float r = rs[row];
                    float v[8];
#pragma unroll
                    for (int j = 0; j < 4; ++j) { v[j] = acc[ai][bj][m][0][j] * r + b0[j]; v[4 + j] = acc[ai][bj][m][1][j] * r + b1[j]; }
                    if (u.pn < 2) {
                        const int g = col >> 4, cc = col & 15, cr = row >> 5, t = row & 31;
                        *(u32x4*)(U + ((size_t)(g * CRP + cr) * KS + t * 16 + cc)) = pack8(v);
                    } else if (u.pn < 4) {
                        const int c = col - 512;
                        *(u32x4*)(UP + (size_t)row * 512 + c) = pack8(v);
                        int hr = -1; size_t ob = 0;
                        if (row < MP) { const int tt = row & 8191; if (tt >= 8177) { hr = tt - 8177; ob = OUT_POOL_P + (size_t)((row >> 13) * 15 + hr) * 512; } }
                        else { const int tt = row & 31; if (tt >= 17) { hr = tt - 17; ob = OUT_POOL_S + (size_t)(((row - MP) >> 5) * 15 + hr) * 512; } }
                        if (hr >= 0) { *(f32x4*)(out + ob + c) = (f32x4){v[0], v[1], v[2], v[3]}; *(f32x4*)(out + ob + c + 4) = (f32x4){v[4], v[5], v[6], v[7]}; }
                    } else {
#pragma unroll
                        for (int j = 0; j < 8; ++j) v[j] = fast_sigmoid(v[j]);
                        *(u32x4*)(GT + (size_t)row * 2048 + (col - 1024)) = pack8(v);
                    }
                }
        }
    }
};
struct EpiSsm {
    static constexpr bool PERM = true, AFTER_DRAIN = false;
    const bf16_t* U; bf16_t* YG; const float* dskip;
    __device__ __forceinline__ void operator()(const f32x4 (&acc)[2][2][4][2], const Unit& u, int wr, int wc, int fr, int fq) const {
        const int g = u.pn >> 1, cr0 = (u.pm - 9 * g) * 256 + wr * 64 + fr;
#pragma unroll
        for (int bj = 0; bj < 2; ++bj) {
            const int col = (u.pn & 1) * 256 + bj * 128 + wc * 32 + 8 * fq, t = col >> 4, cc = col & 15, ch = g * 16 + cc;
            const f32x4 d0 = *(const f32x4*)(dskip + ch), d1 = *(const f32x4*)(dskip + ch + 4);
#pragma unroll
            for (int ai = 0; ai < 2; ++ai)
#pragma unroll
                for (int m = 0; m < 4; ++m) {
                    const int cr = cr0 + ai * 128 + m * 16;
                    if (cr < NCR) {
                        const u32x4 uw = *(const u32x4*)(U + ((size_t)(g * CRP + cr) * KS + col));
                        float uu[8], v[8]; unpack8(uw, uu);
#pragma unroll
                        for (int j = 0; j < 4; ++j) { v[j] = acc[ai][bj][m][0][j] + d0[j] * uu[j]; v[4 + j] = acc[ai][bj][m][1][j] + d1[j] * uu[4 + j]; }
#pragma unroll
                        for (int j = 0; j < 8; ++j) { const float x = v[j]; v[j] = x * fast_sigmoid(1.5957691216f * (x + 0.044715f * x * x * x)); }
                        *(u32x4*)(YG + (size_t)(cr * 32 + t) * 512 + ch) = pack8(v);
                    }
                }
        }
    }
};
struct EpiPool {
    static constexpr bool PERM = true, AFTER_DRAIN = false;
    const bf16_t* GT; bf16_t* PM;
    __device__ __forceinline__ void operator()(const f32x4 (&acc)[2][2][4][2], const Unit& u, int wr, int wc, int fr, int fq) const {
        const int row0 = (u.pm % 258) * 256 + wr * 64 + fr, col0 = u.pn * 256 + wc * 32 + 8 * fq;
#pragma unroll
        for (int ai = 0; ai < 2; ++ai)
#pragma unroll
            for (int m = 0; m < 4; ++m) {
                const int row = row0 + ai * 128 + m * 16;
#pragma unroll
                for (int bj = 0; bj < 2; ++bj) {
                    const int col = col0 + bj * 128;
                    const u32x4 gw = *(const u32x4*)(GT + (size_t)row * 2048 + 1024 + col);
                    float gg[8], v[8]; unpack8(gw, gg);
#pragma unroll
                    for (int j = 0; j < 4; ++j) { v[j] = acc[ai][bj][m][0][j] * gg[j]; v[4 + j] = acc[ai][bj][m][1][j] * gg[4 + j]; }
                    *(u32x4*)(PM + (size_t)row * DM + col) = pack8(v);
                }
            }
    }
};
struct EpiGlu {
    static constexpr bool PERM = true, AFTER_DRAIN = false;
    const bf16_t* GT; const bf16_t* PM; bf16_t* MG; const float* bias;
    __device__ __forceinline__ void operator()(const f32x4 (&acc)[2][2][4][2], const Unit& u, int wr, int wc, int fr, int fq) const {
        const int row0 = u.pm * 256 + wr * 64 + fr, col = u.pn * 128 + wc * 32 + 8 * fq;
        const f32x4 ba0 = *(const f32x4*)(bias + col), ba1 = *(const f32x4*)(bias + col + 4), bg0 = *(const f32x4*)(bias + 1024 + col), bg1 = *(const f32x4*)(bias + 1024 + col + 4);
#pragma unroll
        for (int ai = 0; ai < 2; ++ai)
#pragma unroll
            for (int m = 0; m < 4; ++m) {
                const int row = row0 + ai * 128 + m * 16;
                const u32x4 gw = *(const u32x4*)(GT + (size_t)row * 2048 + col), pw = *(const u32x4*)(PM + (size_t)row * DM + col);
                float gs[8], pm[8], v[8]; unpack8(gw, gs); unpack8(pw, pm);
#pragma unroll
                for (int j = 0; j < 4; ++j) {
                    v[j] = gs[j] * ((acc[ai][0][m][0][j] + ba0[j]) * fast_sigmoid(acc[ai][1][m][0][j] + bg0[j])) + pm[j];
                    v[4 + j] = gs[4 + j] * ((acc[ai][0][m][1][j] + ba1[j]) * fast_sigmoid(acc[ai][1][m][1][j] + bg1[j])) + pm[4 + j];
                }
                *(u32x4*)(MG + (size_t)row * DM + col) = pack8(v);
            }
    }
};

struct ReverseOrder : pg8::StaticOrder {
    __device__ __forceinline__ bool next(int i, Unit& u) const { if (!pg8::StaticOrder::next(i, u)) return false; u.pm = (u.pm & ~31) | ((3 - ((u.pm >> 3) & 3)) << 3) | (u.pm & 7); return true; }
};
struct GroupOrder {
    int G, c;
    __device__ __forceinline__ bool next(int i, Unit& u) const { const int L = i * G + c; if (L >= 512) return false; const int g = L >> 4, r = L & 15; u.pm = g * 9 + (r >> 1); u.pn = g * 2 + (r & 1); return true; }
    __device__ __forceinline__ void a_ready(const Unit&) const {}
    __device__ __forceinline__ void done(const Unit&) const {}
};

struct PoolOrder {
    int G, c;
    __device__ __forceinline__ bool next(int i, Unit& u) const { const int L = i * G + c; if (L >= 258 * 4) return false; const int pn = L & 3, pm = L >> 2; u.pm = (pn >> 1) * 258 + pm; u.pn = pn; return true; }
    __device__ __forceinline__ void a_ready(const Unit&) const {}
    __device__ __forceinline__ void done(const Unit&) const {}
};
template <int K, int NOUT, int MODE, int HO>
__device__ __forceinline__ void conv_weight(LAS float* tile, const float* __restrict__ W, bf16_t* __restrict__ Wt, const float* __restrict__ rowg, int tid, int bid, int nb) {
    constexpr int TK = K / 64, TS = NOUT / 256;
    const int kr = tid >> 4, nc = (tid & 15) * 4;
    for (int t = bid; t < TK * TS; t += nb) {
        const int kt = t % TK, ns = t / TK, k0 = kt * 64;
        f32x4 v[4][2];
#pragma unroll
        for (int s4 = 0; s4 < 4; ++s4) {
            const int s0 = (MODE == 1) ? ((s4 >> 1) * HO + 128 * ns + (s4 & 1) * 64) : (ns * 256 + s4 * 64);
#pragma unroll
            for (int p = 0; p < 2; ++p) v[s4][p] = *(const f32x4*)(W + (size_t)(k0 + kr + 32 * p) * NOUT + s0 + nc);
        }
        const float g0 = rowg ? rowg[k0 + kr] : 1.0f, g1 = rowg ? rowg[k0 + kr + 32] : 1.0f;
#pragma unroll
        for (int s4 = 0; s4 < 4; ++s4)
#pragma unroll
            for (int p = 0; p < 2; ++p) { const float gk = p ? g1 : g0; LAS float* tp = tile + s4 * 4160 + (kr + 32 * p) * 65 + nc;
                tp[0] = v[s4][p][0] * gk; tp[1] = v[s4][p][1] * gk; tp[2] = v[s4][p][2] * gk; tp[3] = v[s4][p][3] * gk; }
        __syncthreads();
        const int n = tid >> 3, k8 = (tid & 7) * 8;
#pragma unroll
        for (int s4 = 0; s4 < 4; ++s4) {
            float o[8];
#pragma unroll
            for (int i = 0; i < 8; ++i) o[i] = tile[s4 * 4160 + (k8 + i) * 65 + n];
            *(u32x4*)(Wt + (size_t)(ns * 256 + s4 * 64 + n) * K + k0 + k8) = pack8(o);
        }
        __syncthreads();
    }
}

template <int MODE, int NR>
__device__ __forceinline__ void row_phase(const Params& p, const float* __restrict__ sumsq, const float* __restrict__ gain, float* __restrict__ rstd_out, const float* __restrict__ rstd0, const int rbeg, const int rend, int gw, int nw, int lane) {
    const bf16_t* R = (const bf16_t*)(p.ws + WS_R); bf16_t* H = (bf16_t*)(p.ws + WS_H); bf16_t* XNo = (bf16_t*)(p.ws + WS_XN);
    const bf16_t* B = (MODE == 1) ? (const bf16_t*)H : (const bf16_t*)(p.ws + WS_XN);
    const float scale = (MODE == 1) ? 1.0f : 0.5f;
    float g[2][8];
#pragma unroll
    for (int i = 0; i < 2; ++i) { const f32x4 a = *(const f32x4*)(gain + i * 512 + lane * 8), b = *(const f32x4*)(gain + i * 512 + lane * 8 + 4);
#pragma unroll
        for (int j = 0; j < 4; ++j) { g[i][j] = a[j] * scale; g[i][4 + j] = b[j] * scale; } }
    for (int row0 = rbeg + gw; row0 < rend; row0 += NR * nw) {
        u32x4 rw[NR][2], hw[NR][2]; float sq[NR], bs[NR];
#pragma unroll
        for (int q = 0; q < NR; ++q) {
            const int row = (row0 + q * nw < rend) ? row0 + q * nw : row0;
            sq[q] = sumsq[row]; bs[q] = (MODE != 1) ? rstd0[row] : 1.0f;
#pragma unroll
            for (int i = 0; i < 2; ++i) { const size_t off = (size_t)row * DM + i * 512 + lane * 8; rw[q][i] = __builtin_nontemporal_load((const u32x4*)(R + off)); hw[q][i] = __builtin_nontemporal_load((const u32x4*)(B + off)); }
        }
#pragma unroll
        for (int q = 0; q < NR; ++q) {
            const int row = row0 + q * nw;
            if (row >= rend) break;
            const float rstd = rsqrtf(sq[q] * (1.0f / 1024.0f) + EPS);
            const float binv = (MODE != 1) ? 1.0f / bs[q] : 1.0f;
            float ss = 0.f; float hk[2][8];
#pragma unroll
            for (int i = 0; i < 2; ++i) {
                const size_t off = (size_t)row * DM + i * 512 + lane * 8;
                float r[8], b[8]; float (&h)[8] = hk[i]; unpack8(rw[q][i], r); unpack8(hw[q][i], b);
#pragma unroll
                for (int j = 0; j < 8; ++j) { h[j] = b[j] * binv + r[j] * rstd * g[i][j]; ss += h[j] * h[j]; }
                if (MODE == 2) { float* o = p.out + OUT_Y + off; __builtin_nontemporal_store((f32x4){h[0], h[1], h[2], h[3]}, (f32x4*)o); __builtin_nontemporal_store((f32x4){h[4], h[5], h[6], h[7]}, (f32x4*)(o + 4)); }
                else if (MODE == 0) *(u32x4*)(H + off) = pack8(h);
            }
            if (MODE != 2) { ss = wave_sum(ss); const float rs = rsqrtf(ss * (1.0f / 1024.0f) + EPS);
                if (lane == 0) rstd_out[row] = rs;
                if (MODE == 1) {
#pragma unroll
                    for (int i = 0; i < 2; ++i) { float z[8];
#pragma unroll
                        for (int j = 0; j < 8; ++j) z[j] = hk[i][j] * rs;
                        *(u32x4*)(XNo + (size_t)row * DM + i * 512 + lane * 8) = pack8(z); } } }
        }
    }
}

template <int K>
__device__ __forceinline__ void small_down(LAS float* red, const bf16_t* __restrict__ A, const bf16_t* __restrict__ Bt, bf16_t* __restrict__ O, float* sumsq, int bid, int nb, int tid, int wid, int lane) {
    constexpr int KW = K / 8;
    for (int task = bid; task < 256; task += nb) {
        const int rb = task >> 4, cb = task & 15;
        const bf16_t* Ap = A + (size_t)(MP + rb * 32 + (lane & 31)) * K + wid * KW + 8 * (lane >> 5);
        const bf16_t* Bp = Bt + (size_t)(cb * 64 + (lane & 31)) * K + wid * KW + 8 * (lane >> 5);
        f32x16 acc0, acc1;
#pragma unroll
        for (int j = 0; j < 16; ++j) { acc0[j] = 0.f; acc1[j] = 0.f; }
#pragma unroll 4
        for (int k0 = 0; k0 < KW; k0 += 16) {
            const bf16x8 a = *(const bf16x8*)(Ap + k0), b0 = *(const bf16x8*)(Bp + k0), b1 = *(const bf16x8*)(Bp + (size_t)32 * K + k0);
            acc0 = __builtin_amdgcn_mfma_f32_32x32x16_bf16(a, b0, acc0, 0, 0, 0); acc1 = __builtin_amdgcn_mfma_f32_32x32x16_bf16(a, b1, acc1, 0, 0, 0);
        }
#pragma unroll
        for (int j = 0; j < 16; ++j) { red[((wid * 2 + 0) * 16 + j) * 64 + lane] = acc0[j]; red[((wid * 2 + 1) * 16 + j) * 64 + lane] = acc1[j]; }
        __syncthreads();
#pragma unroll
        for (int i = 0; i < 4; ++i) {
            const int idx = tid + 512 * i; float s = 0.f;
#pragma unroll
            for (int w = 0; w < 8; ++w) s += red[w * 2048 + idx];
            const int q = idx >> 10, j = (idx >> 6) & 15;
            const int row = MP + rb * 32 + (j & 3) + 8 * (j >> 2) + 4 * (lane >> 5), col = cb * 64 + 32 * q + (lane & 31);
            O[(size_t)row * DM + col] = (bf16_t)(cvt_pk_bf16(s, 0.f) & 0xffffu);
            float sq = s * s;
            sq += __shfl_xor(sq, 16); sq += __shfl_xor(sq, 8); sq += __shfl_xor(sq, 4); sq += __shfl_xor(sq, 2); sq += __shfl_xor(sq, 1);
            if ((lane & 31) == 0) atomicAdd(sumsq + row, sq);
        }
        __syncthreads();
    }
}


__device__ __forceinline__ void small_ssm(const bf16_t* __restrict__ U, const bf16_t* __restrict__ Bt, bf16_t* __restrict__ YG, const float* __restrict__ dskip, int gw, int nw, int lane) {
    for (int task = gw; task < 32 * 16; task += nw) {
        const int g = task >> 4, cb = task & 15;
        const bf16_t* Ap = U + (size_t)(g * CRP + 2048 + (lane & 31)) * KS + 8 * (lane >> 5);
        const bf16_t* Bp = Bt + (size_t)(g * 512 + cb * 32 + (lane & 31)) * KS + 8 * (lane >> 5);
        f32x16 acc;
#pragma unroll
        for (int j = 0; j < 16; ++j) acc[j] = 0.f;
#pragma unroll 8
        for (int k0 = 0; k0 < KS; k0 += 16) { const bf16x8 a = *(const bf16x8*)(Ap + k0), b = *(const bf16x8*)(Bp + k0); acc = __builtin_amdgcn_mfma_f32_32x32x16_bf16(a, b, acc, 0, 0, 0); }
        const int col = cb * 32 + (lane & 31), t = col >> 4, c = col & 15; const float d = dskip[g * 16 + c];
#pragma unroll
        for (int j = 0; j < 8; ++j) {
            const int cr = 2048 + (j & 3) + 8 * (j >> 2) + 4 * (lane >> 5);
            const float uu = __uint_as_float((unsigned)U[(size_t)(g * CRP + cr) * KS + col] << 16);
            const float x = acc[j] + d * uu, v = x * fast_sigmoid(1.5957691216f * (x + 0.044715f * x * x * x));
            YG[(size_t)(cr * 32 + t) * 512 + g * 16 + c] = (bf16_t)(cvt_pk_bf16(v, 0.f) & 0xffffu);
        }
    }
}

__device__ __forceinline__ void grid_barrier(unsigned* bar, unsigned epoch, int bid, int nb, int tid) {
    asm volatile("s_waitcnt vmcnt(0) lgkmcnt(0)" ::: "memory");
    __syncthreads();
    if (tid == 0) {
        __builtin_amdgcn_fence(__ATOMIC_RELEASE, "agent"); asm volatile("s_waitcnt vmcnt(0)" ::: "memory");
        const int j = bid & 7; const unsigned ng = (unsigned)((nb - j + 7) >> 3);
        const unsigned old = __hip_atomic_fetch_add(bar + 64 * j, 1u, __ATOMIC_RELAXED, __HIP_MEMORY_SCOPE_AGENT);
        if (old == ng * epoch - 1u) {
            const unsigned ngroups = (unsigned)(nb < 8 ? nb : 8);
            const unsigned oldt = __hip_atomic_fetch_add(bar + 64 * 8, 1u, __ATOMIC_RELAXED, __HIP_MEMORY_SCOPE_AGENT);
            if (oldt == ngroups * epoch - 1u) {
#pragma unroll
                for (int q = 0; q < 8; ++q) __hip_atomic_store(bar + 64 * (9 + q), epoch, __ATOMIC_RELAXED, __HIP_MEMORY_SCOPE_AGENT);
            }
        }
        unsigned spins = 0;
        while (__hip_atomic_load(bar + 64 * (9 + j), __ATOMIC_RELAXED, __HIP_MEMORY_SCOPE_AGENT) < epoch) { __builtin_amdgcn_s_sleep(1); if (++spins > (1u << 24)) break; }
        __builtin_amdgcn_fence(__ATOMIC_ACQUIRE, "agent"); asm volatile("s_waitcnt vmcnt(0)" ::: "memory");
    }
    __syncthreads();
}

__device__ __forceinline__ void p0_xn(const Params& p, bf16_t* __restrict__ XN, float* __restrict__ RSTD, const int rbeg, const int rend, const int gw, const int nw, const int lane) {
        for (int row0 = rbeg + gw; row0 < rend; row0 += 2 * nw) {
            const bool two = (row0 + nw) < rend;
            f32x4 v[2][4];
#pragma unroll
            for (int q = 0; q < 2; ++q) { const int row = (q == 0 || two) ? row0 + q * nw : row0;
                const float* xr = (row < MP) ? (p.in[0] + (size_t)row * DM) : (p.in[1] + (size_t)(row - MP) * DM);
#pragma unroll
                for (int i = 0; i < 4; ++i) v[q][i] = __builtin_nontemporal_load((const f32x4*)(xr + i * 256 + lane * 4)); }
#pragma unroll
            for (int q = 0; q < 2; ++q) {
                if (q == 1 && !two) break;
                const int row = row0 + q * nw; float ss = 0.f;
#pragma unroll
                for (int i = 0; i < 4; ++i) ss += v[q][i][0] * v[q][i][0] + v[q][i][1] * v[q][i][1] + v[q][i][2] * v[q][i][2] + v[q][i][3] * v[q][i][3];
                ss = wave_sum(ss);
                const float rs = rsqrtf(ss * (1.0f / 1024.0f) + EPS);
                if (lane == 0) RSTD[row] = rs;
#pragma unroll
                for (int i = 0; i < 4; ++i) { typedef unsigned u32x2 __attribute__((ext_vector_type(2))); u32x2 w; w.x = cvt_pk_bf16(v[q][i][0] * rs, v[q][i][1] * rs); w.y = cvt_pk_bf16(v[q][i][2] * rs, v[q][i][3] * rs);
                    *(u32x2*)(XN + (size_t)row * DM + i * 256 + lane * 4) = w; }
            }
        }
}

__device__ __forceinline__ void sub_barrier(unsigned* word, unsigned count, int tid) {
    asm volatile("s_waitcnt vmcnt(0) lgkmcnt(0)" ::: "memory");
    __syncthreads();
    if (tid == 0) {
        __builtin_amdgcn_fence(__ATOMIC_RELEASE, "agent"); asm volatile("s_waitcnt vmcnt(0)" ::: "memory");
        __hip_atomic_fetch_add(word, 1u, __ATOMIC_RELAXED, __HIP_MEMORY_SCOPE_AGENT);
        unsigned spins = 0;
        while (__hip_atomic_load(word, __ATOMIC_RELAXED, __HIP_MEMORY_SCOPE_AGENT) < count) { __builtin_amdgcn_s_sleep(1); if (++spins > (1u << 24)) break; }
        __builtin_amdgcn_fence(__ATOMIC_ACQUIRE, "agent"); asm volatile("s_waitcnt vmcnt(0)" ::: "memory");
    }
    __syncthreads();
}
struct OneUnit {
    int pm, pn;
    __device__ __forceinline__ bool next(int i, Unit& u) const { if (i != 0) return false; u.pm = pm; u.pn = pn; return true; }
    __device__ __forceinline__ void a_ready(const Unit&) const {}
    __device__ __forceinline__ void done(const Unit&) const {}
};
#define GRID_SYNC() grid_barrier((unsigned*)(ws + WS_BAR), ++epoch, bid, nb, tid)
#define GRID_SYNC_CG() do { asm volatile("s_waitcnt vmcnt(0) lgkmcnt(0)" ::: "memory"); __syncthreads(); if (wid == 0) { __builtin_amdgcn_fence(__ATOMIC_RELEASE, "agent"); asm volatile("s_waitcnt vmcnt(0)" ::: "memory"); } grid.sync(); __builtin_amdgcn_fence(__ATOMIC_ACQUIRE, "agent"); asm volatile("s_waitcnt vmcnt(0)" ::: "memory"); } while (0)
__device__ __forceinline__ void pooled_row(float (&v)[8], int tt, int r0, int oct, int pos0, bool smp, const bf16_t* __restrict__ UP, const float* __restrict__ cache) {
    if (tt >= 0 || (!smp && pos0 + tt >= 0)) unpack8(*(const u32x4*)(UP + (size_t)(r0 + tt) * 512 + oct * 8), v);
    else if (smp) { const f32x4 a = *(const f32x4*)(cache + (size_t)(15 + tt) * 512), b = *(const f32x4*)(cache + (size_t)(15 + tt) * 512 + 4);
#pragma unroll
        for (int j = 0; j < 4; ++j) { v[j] = a[j]; v[4 + j] = b[j]; } }
    else {
#pragma unroll
        for (int j = 0; j < 8; ++j) v[j] = 0.f; }
}
__device__ __forceinline__ void pooled_task(const int i, const int tb, const int nrows, const bf16_t* __restrict__ UP, bf16_t* __restrict__ POOLED, const Params& p) {
    const int oct = i & 63, cr = i >> 6, gi = oct >> 4, w = 2 << gi, r0 = cr * 32;
    const bool smp = cr >= 2048; const int pos0 = smp ? 2048 : (cr & 255) * 32;
    const float* cache = p.in[4] + (size_t)(cr - 2048) * 15 * 512 + oct * 8;
    float S[8];
#pragma unroll
    for (int j = 0; j < 8; ++j) S[j] = 0.f;
    for (int tt = tb + 1 - w; tt < tb; ++tt) {
        float v[8]; pooled_row(v, tt, r0, oct, pos0, smp, UP, cache);
#pragma unroll
        for (int j = 0; j < 8; ++j) S[j] += v[j];
    }
    for (int t0 = tb; t0 < tb + nrows; t0 += 8) {
        float cur[8][8], old[8][8];
#pragma unroll
        for (int q = 0; q < 8; ++q) { pooled_row(cur[q], t0 + q, r0, oct, pos0, smp, UP, cache);
            if (t0 + q > tb) pooled_row(old[q], t0 + q - w, r0, oct, pos0, smp, UP, cache);
            else {
#pragma unroll
                for (int j = 0; j < 8; ++j) old[q][j] = 0.f; } }
#pragma unroll
        for (int q = 0; q < 8; ++q) {
            const int pos = pos0 + t0 + q; const float inv = 1.0f / (float)((pos + 1 < w) ? (pos + 1) : w);
            float o[8];
#pragma unroll
            for (int j = 0; j < 8; ++j) { S[j] += cur[q][j] - old[q][j]; o[j] = S[j] * inv - cur[q][j]; }
            *(u32x4*)(POOLED + ((size_t)(oct >> 5) * MT + (size_t)(r0 + t0 + q)) * 256 + (oct & 31) * 8) = pack8(o);
        }
    }
}
#define POOLED_TASK(i) pooled_task((i), 0, 32, UP, POOLED, p)
__global__ void __launch_bounds__(512) fwd_megakernel(Params p) {
    extern __shared__ __attribute__((aligned(16))) unsigned char shm[];
    cg::grid_group grid = cg::this_grid();
    LAS unsigned char* lds = (LAS unsigned char*)shm;
    const int tid = threadIdx.x, lane = tid & 63, wid = __builtin_amdgcn_readfirstlane(tid >> 6);
    const int bid = blockIdx.x, nb = gridDim.x, gw = bid * 8 + wid, nw = nb * 8, gt = bid * 512 + tid, nt = nb * 512;
    unsigned char* ws = p.ws; unsigned char* dob = (unsigned char*)p.out; unsigned epoch = 0u;
    bf16_t* XN = (bf16_t*)(ws + WS_XN); bf16_t* HID = (bf16_t*)(ws + WS_HID); bf16_t* R = (bf16_t*)(ws + WS_R);
    bf16_t* GATES = (bf16_t*)(ws + WS_GATES); bf16_t* POOLED = (bf16_t*)(ws + WS_POOLED); bf16_t* UP = (bf16_t*)(ws + WS_UP); bf16_t* PMb = (bf16_t*)(ws + WS_PM);
    bf16_t* MERGED = (bf16_t*)(ws + WS_MERGED); float* Eb = (float*)(ws + WS_E);
    bf16_t* Uq = (bf16_t*)(dob + DO_U); bf16_t* YG = (bf16_t*)(dob + DO_YG);
    bf16_t* W1IN = (bf16_t*)(ws + WS_W1IN); bf16_t* W1OUT = (bf16_t*)(ws + WS_W1OUT); bf16_t* WIN = (bf16_t*)(ws + WS_WIN); bf16_t* WGLU = (bf16_t*)(ws + WS_WGLU);
    bf16_t* WPOOL = (bf16_t*)(ws + WS_WPOOL); bf16_t* WOUT = (bf16_t*)(ws + WS_WOUT); bf16_t* W2IN = (bf16_t*)(ws + WS_W2IN); bf16_t* W2OUT = (bf16_t*)(ws + WS_W2OUT);
    bf16_t* SSMBT = (bf16_t*)(ws + WS_SSMBT); bf16_t* WEND = (bf16_t*)(ws + WS_WEND);
    float* RSTD = (float*)(ws + WS_RSTD); bf16_t* Hb = (bf16_t*)(ws + WS_H);
    float* KLAG = (float*)(ws + WS_KLAG); float* LP = (float*)(ws + WS_LP); float* BB = (float*)(ws + WS_BB); float* SUMSQ = (float*)(ws + WS_SUMSQ);

    {
        {
            constexpr int NS1 = 44;
            LAS float* tile = (LAS float*)lds;
            if (bid < NS1) {
                conv_weight<1024, 5632, 1, 2816>(tile, p.in[6], W1IN, p.in[5], tid, bid, NS1);
                p0_xn(p, XN, RSTD, MP, MT, bid * 8 + wid, NS1 * 8, lane);
                sub_barrier((unsigned*)(ws + WS_BAR) + 64 * 19, NS1, tid);
                { pg8::Gemm g{XN, W1IN, MT, 2 * DFF, DM}; OneUnit S{256 + bid / 22, bid % 22}; EpiFfnUp E{HID}; pg8::gemm_phase<EpiFfnUp, OneUnit, false>(lds, g, S, E, nullptr); }
                conv_weight<2816, 1024, 0, 0>(tile, p.in[7], W1OUT, nullptr, tid, bid, NS1);
            } else {
                conv_weight<1024, 3072, 0, 0>(tile, p.in[10], WIN, p.in[9], tid, bid - NS1, nb - NS1);
                p0_xn(p, XN, RSTD, 0, MP, (bid - NS1) * 8 + wid, (nb - NS1) * 8, lane);
            }
        }
        for (int i = gt; i < 1024 * 32; i += nt) {
            const int n = i >> 5, k8 = (i & 31) * 8, gi = n >> 8, ch = (gi >> 1) * 256 + k8; float v[8];
#pragma unroll
            for (int j = 0; j < 8; ++j) v[j] = 0.f;
            if ((ch >> 7) == gi) { const float sc = p.in[23][n];
#pragma unroll
                for (int j = 0; j < 8; ++j) v[j] = p.in[22][(size_t)gi * 32768 + (size_t)((ch & 127) + j) * 256 + (n & 255)] * sc; }
            *(u32x4*)(WPOOL + (size_t)n * 256 + k8) = pack8(v);
        }
        for (int i = gt; i < 32 * 33 * 64; i += nt) {
            const int pp = i & 63, j = (i >> 6) % 33, g = i / (33 * 64);
            const float dt = expf(p.in[14][g]), lr = p.in[12][g * 64 + pp], li = p.in[13][g * 64 + pp];
            const float mag = expf((float)j * lr * dt);
            const double turns = (double)j * ((double)li * (double)dt) * 0.15915494309189533577;
            const float fr = (float)(turns - rint(turns));
            LP[(size_t)i * 2] = mag * __builtin_amdgcn_cosf(fr); LP[(size_t)i * 2 + 1] = mag * __builtin_amdgcn_sinf(fr);
        }
        for (int i = gt; i < 32 * 64; i += nt) {
            const int pp = i & 63, g = i >> 6;
            const float dt = expf(p.in[14][g]), lr = p.in[12][i], li = p.in[13][i];
            const float mag = expf(lr * dt);
            const double turns = ((double)li * (double)dt) * 0.15915494309189533577;
            const float fr = (float)(turns - rint(turns));
            const float abr = mag * __builtin_amdgcn_cosf(fr), abi = mag * __builtin_amdgcn_sinf(fr);
            const float den = lr * lr + li * li, nr = abr - 1.0f;
            const float fre = (nr * lr + abi * li) / den, fim = (abi * lr - nr * li) / den;
#pragma unroll
            for (int c = 0; c < 16; ++c) { const float br = p.in[15][(size_t)i * 16 + c], bi = p.in[16][(size_t)i * 16 + c];
                BB[((size_t)i * 16 + c) * 2] = fre * br - fim * bi; BB[((size_t)i * 16 + c) * 2 + 1] = fre * bi + fim * br; }
            (void)pp;
        }
        for (int i = gt; i < 3 * MT; i += nt) SUMSQ[i] = 0.f;
        if (gt < 64) ((unsigned*)(ws + WS_FLAGS))[gt] = 0u;
    }
    if (nb == 0) grid.sync();
    GRID_SYNC();

    { pg8::Gemm g{XN, W1IN, MP, 2 * DFF, DM}; pg8::StaticOrder S; S.init(MP, 2 * DFF, nb, bid); EpiFfnUp E{HID}; pg8::gemm_phase<EpiFfnUp, pg8::StaticOrder, false>(lds, g, S, E, nullptr); }
    {
        for (int task = gw; task < 32 * 32; task += nw) {
            const int g = task >> 5, j = task & 31, c2 = lane & 15, c1b = lane >> 4;
            const float lpr = LP[((size_t)(g * 33 + j) * 64 + lane) * 2], lpi = LP[((size_t)(g * 33 + j) * 64 + lane) * 2 + 1];
            float a0 = 0.f, a1 = 0.f, a2 = 0.f, a3 = 0.f;
#pragma unroll 4
            for (int pp = 0; pp < 64; ++pp) {
                const float lre = __shfl(lpr, pp), lim = __shfl(lpi, pp);
                const float bre = BB[((size_t)(g * 64 + pp) * 16 + c2) * 2], bim = BB[((size_t)(g * 64 + pp) * 16 + c2) * 2 + 1];
                const float tr = lre * bre - lim * bim, ti = lre * bim + lim * bre;
                const size_t cb = (size_t)(g * 16 + c1b) * 64 + pp;
                a0 += p.in[17][cb] * tr - p.in[18][cb] * ti;
                a1 += p.in[17][cb + 4 * 64] * tr - p.in[18][cb + 4 * 64] * ti;
                a2 += p.in[17][cb + 8 * 64] * tr - p.in[18][cb + 8 * 64] * ti;
                a3 += p.in[17][cb + 12 * 64] * tr - p.in[18][cb + 12 * 64] * ti;
            }
            float* kd = KLAG + (size_t)task * 256 + c2;
            kd[(c1b) * 16] = a0; kd[(c1b + 4) * 16] = a1; kd[(c1b + 8) * 16] = a2; kd[(c1b + 12) * 16] = a3;
        }
        for (int i = gt; i < 32 * 128 * 512; i += nt) {
            const int k = i & 511, pq = (i >> 9) & 127, g = i >> 16, t1 = k >> 4, c2 = k & 15, pp = pq & 63;
            const float lre = LP[((size_t)(g * 33 + 31 - t1) * 64 + pp) * 2], lim = LP[((size_t)(g * 33 + 31 - t1) * 64 + pp) * 2 + 1];
            const float bre = BB[((size_t)(g * 64 + pp) * 16 + c2) * 2], bim = BB[((size_t)(g * 64 + pp) * 16 + c2) * 2 + 1];
            const float v = (pq < 64) ? (lre * bre - lim * bim) : (lre * bim + lim * bre);
            WEND[i] = (bf16_t)(cvt_pk_bf16(v, 0.f) & 0xffffu);
        }
        for (int i = gt; i < 32 * 512 * 128; i += nt) {
            const int pq = i & 127, n = (i >> 7) & 511, g = i >> 16, t = n >> 4, c1 = n & 15, pp = pq & 63;
            const float cre = p.in[17][(size_t)(g * 16 + c1) * 64 + pp], cim = p.in[18][(size_t)(g * 16 + c1) * 64 + pp];
            const float lre = LP[((size_t)(g * 33 + t + 1) * 64 + pp) * 2], lim = LP[((size_t)(g * 33 + t + 1) * 64 + pp) * 2 + 1];
            const float v = (pq < 64) ? (cre * lre - cim * lim) : -(cre * lim + cim * lre);
            SSMBT[((size_t)(g * 512 + n)) * KS + 512 + pq] = (bf16_t)(cvt_pk_bf16(v, 0.f) & 0xffffu);
        }
    }
    GRID_SYNC();

    { pg8::Gemm g{HID, W1OUT, MP, DM, DFF}; ReverseOrder S; S.init(MP, DM, nb, bid); EpiDown E{R, SUMSQ}; pg8::gemm_phase<EpiDown, ReverseOrder, false>(lds, g, S, E, nullptr); }
    small_down<DFF>((LAS float*)lds, HID, W1OUT, R, SUMSQ, bid, nb, tid, wid, lane);
    for (int i = gt; i < 32 * 512 * 64; i += nt) {
        const int k8 = (i & 63) * 8, n = (i >> 6) & 511, g = i >> 15, t = n >> 4, c1 = n & 15, t1 = k8 >> 4, c20 = k8 & 15; float v[8];
#pragma unroll
        for (int j = 0; j < 8; ++j) v[j] = (t1 <= t) ? KLAG[(size_t)((g * 32 + (t - t1)) * 16 + c1) * 16 + c20 + j] : 0.f;
        *(u32x4*)(SSMBT + (size_t)(g * 512 + n) * KS + k8) = pack8(v);
    }
    GRID_SYNC();

    {
        constexpr int NS3 = 24;
        if (bid < NS3) {
            row_phase<0, 4>(p, SUMSQ, p.in[8], RSTD + MT, RSTD, MP, MT, bid * 8 + wid, NS3 * 8, lane);
            sub_barrier((unsigned*)(ws + WS_BAR) + 64 * 17, NS3, tid);
            pg8::Gemm g{Hb, WIN, MT, NPROJ, DM}; OneUnit S{256 + bid / 12, bid % 12}; EpiInProj E{Uq, UP, GATES, p.in[11], p.out, RSTD + MT};
            pg8::gemm_phase<EpiInProj, OneUnit, false>(lds, g, S, E, nullptr);
            { LAS float* tile = (LAS float*)lds;
              conv_weight<512, 2048, 1, 1024>(tile, p.in[20], WGLU, nullptr, tid, bid, NS3);
              conv_weight<1024, 1024, 0, 0>(tile, p.in[24], WOUT, nullptr, tid, bid, NS3); }
        } else row_phase<0, 4>(p, SUMSQ, p.in[8], RSTD + MT, RSTD, 0, MP, (bid - NS3) * 8 + wid, (nb - NS3) * 8, lane);
    }
    GRID_SYNC();

    { pg8::Gemm g{Hb, WIN, MP, NPROJ, DM}; pg8::StaticOrder S; S.init(MP, NPROJ, nb, bid); EpiInProj E{Uq, UP, GATES, p.in[11], p.out, RSTD + MT}; pg8::gemm_phase<EpiInProj, pg8::StaticOrder, false>(lds, g, S, E, nullptr); }
    GRID_SYNC();

    {
        for (int task = gw; task < 32 * 64; task += nw) {
            const int g = task >> 6, cr0 = (task & 63) * 32;
            f32x16 acc[4];
#pragma unroll
            for (int q = 0; q < 4; ++q)
#pragma unroll
                for (int j = 0; j < 16; ++j) acc[q][j] = 0.f;
            const bf16_t* Ab = Uq + ((size_t)(g * CRP + cr0 + (lane & 31)) * KS + 8 * (lane >> 5));
            const bf16_t* Bb = WEND + ((size_t)(g * 128 + (lane & 31)) * 512 + 8 * (lane >> 5));
#pragma unroll 4
            for (int k0 = 0; k0 < 512; k0 += 16) {
                const bf16x8 a = *(const bf16x8*)(Ab + k0);
#pragma unroll
                for (int q = 0; q < 4; ++q) { const bf16x8 b = *(const bf16x8*)(Bb + (size_t)q * 32 * 512 + k0); acc[q] = __builtin_amdgcn_mfma_f32_32x32x16_bf16(a, b, acc[q], 0, 0, 0); }
            }
#pragma unroll
            for (int q = 0; q < 4; ++q)
#pragma unroll
                for (int j = 0; j < 16; ++j) { const int row = (j & 3) + 8 * (j >> 2) + 4 * (lane >> 5); Eb[(size_t)(g * CRP + cr0 + row) * 128 + q * 32 + (lane & 31)] = acc[q][j]; }
        }
        for (int i = gt; i < 2048 * 64; i += nt) POOLED_TASK(i);
        for (int i = gt; i < 16 * 64 * 4; i += nt) pooled_task((2048 + (i >> 8)) * 64 + ((i >> 2) & 63), 8 * (i & 3), 8, UP, POOLED, p);
    }
    GRID_SYNC();

    {
        for (int task = gw; task < 8 * 32 + 16 * 32; task += nw) {
            const bool smp = task >= 256; const int tk = smp ? task - 256 : task, b = tk >> 5, g = tk & 31;
            const float l32r = LP[((size_t)(g * 33 + 32) * 64 + lane) * 2], l32i = LP[((size_t)(g * 33 + 32) * 64 + lane) * 2 + 1];
            float sr = 0.f, si = 0.f; int cr = b * 256, nk = 256;
            if (smp) { sr = p.in[2][(size_t)(b * 32 + g) * 64 + lane]; si = p.in[3][(size_t)(b * 32 + g) * 64 + lane]; cr = 2048 + b; nk = 1; }
            if (smp) {
                const size_t base = (size_t)(g * CRP + cr);
                Uq[base * KS + 512 + lane] = (bf16_t)(cvt_pk_bf16(sr, 0.f) & 0xffffu);
                Uq[base * KS + 576 + lane] = (bf16_t)(cvt_pk_bf16(si, 0.f) & 0xffffu);
                float er = 0.f, ei = 0.f;
                { const bf16_t* ur = Uq + base * KS; const bf16_t* wre = WEND + (size_t)(g * 128 + lane) * 512; const bf16_t* wim = wre + (size_t)64 * 512;
                  for (int k = 0; k < 512; k += 8) { float uu[8], a8[8], b8[8]; unpack8(*(const u32x4*)(ur + k), uu); unpack8(*(const u32x4*)(wre + k), a8); unpack8(*(const u32x4*)(wim + k), b8);
                      for (int j = 0; j < 8; ++j) { er += uu[j] * a8[j]; ei += uu[j] * b8[j]; } } }
                const float nr = l32r * sr - l32i * si + er, ni = l32r * si + l32i * sr + ei;
                sr = nr; si = ni;
            } else {
                for (int k0 = 0; k0 < 256; k0 += 16) {
                    float er[16], ei[16];
#pragma unroll
                    for (int q = 0; q < 16; ++q) { const size_t base = (size_t)(g * CRP + cr + k0 + q); er[q] = Eb[base * 128 + lane]; ei[q] = Eb[base * 128 + 64 + lane]; }
#pragma unroll
                    for (int q = 0; q < 16; ++q) {
                        const size_t base = (size_t)(g * CRP + cr + k0 + q);
                        Uq[base * KS + 512 + lane] = (bf16_t)(cvt_pk_bf16(sr, 0.f) & 0xffffu);
                        Uq[base * KS + 576 + lane] = (bf16_t)(cvt_pk_bf16(si, 0.f) & 0xffffu);
                        const float nr = l32r * sr - l32i * si + er[q], ni = l32r * si + l32i * sr + ei[q];
                        sr = nr; si = ni;
                    }
                }
            }
            const size_t o = (size_t)(b * 32 + g) * 64 + lane;
            if (smp) { p.out[OUT_RE_S + o] = sr; p.out[OUT_IM_S + o] = si; } else { p.out[OUT_RE_P + o] = sr; p.out[OUT_IM_P + o] = si; }
        }
    }
    {
        const int sb = (nb > 64) ? 32 : 0;
        if (bid >= sb) {
        { int kpool = 256; asm volatile("" : "+s"(kpool));
          pg8::Gemm g{POOLED, WPOOL, 2 * MT, DM, kpool}; PoolOrder S{nb - sb, bid - sb}; EpiPool E{GATES, PMb}; pg8::gemm_phase<EpiPool, PoolOrder, false>(lds, g, S, E, nullptr); }
        }
    }
    GRID_SYNC();

    { pg8::Gemm g{Uq, SSMBT, 32 * CRP, 32 * 512, KS}; GroupOrder S{nb, bid}; EpiSsm E{Uq, YG, p.in[19]}; pg8::gemm_phase<EpiSsm, GroupOrder, false>(lds, g, S, E, nullptr); }
    small_ssm(Uq, SSMBT, YG, p.in[19], gw, nw, lane);
    GRID_SYNC();

    { pg8::Gemm g{YG, WGLU, MT, 2 * DM, 512}; pg8::StaticOrder S; S.init(MT, 2 * DM, nb, bid); EpiGlu E{GATES, PMb, MERGED, p.in[21]}; pg8::gemm_phase<EpiGlu, pg8::StaticOrder, false>(lds, g, S, E, nullptr); }
    { const int t6 = (258 * 8) % nb;
      if (bid >= t6) { LAS float* tile = (LAS float*)lds;
        conv_weight<1024, 5632, 1, 2816>(tile, p.in[27], W2IN, p.in[26], tid, bid - t6, nb - t6);
        conv_weight<2816, 1024, 0, 0>(tile, p.in[28], W2OUT, nullptr, tid, bid - t6, nb - t6); } }
    GRID_SYNC();

    { pg8::Gemm g{MERGED, WOUT, MP, DM, DM}; pg8::StaticOrder S; S.init(MP, DM, nb, bid); EpiDown E{R, SUMSQ + MT}; pg8::gemm_phase<EpiDown, pg8::StaticOrder, false>(lds, g, S, E, nullptr); }
    small_down<DM>((LAS float*)lds, MERGED, WOUT, R, SUMSQ + MT, bid, nb, tid, wid, lane);
    GRID_SYNC();

    {
        constexpr int NS8 = 44;
        if (bid < NS8) {
            row_phase<1, 4>(p, SUMSQ + MT, p.in[25], RSTD + 2 * MT, nullptr, MP, MT, bid * 8 + wid, NS8 * 8, lane);
            sub_barrier((unsigned*)(ws + WS_BAR) + 64 * 18, NS8, tid);
            pg8::Gemm g{XN, W2IN, MT, 2 * DFF, DM}; OneUnit S{256 + bid / 22, bid % 22}; EpiFfnUp E{HID};
            pg8::gemm_phase<EpiFfnUp, OneUnit, false>(lds, g, S, E, nullptr);
        } else row_phase<1, 4>(p, SUMSQ + MT, p.in[25], RSTD + 2 * MT, nullptr, 0, MP, (bid - NS8) * 8 + wid, (nb - NS8) * 8, lane);
    }
    GRID_SYNC();

    { pg8::Gemm g{XN, W2IN, MP, 2 * DFF, DM}; pg8::StaticOrder S; S.init(MP, 2 * DFF, nb, bid); EpiFfnUp E{HID}; pg8::gemm_phase<EpiFfnUp, pg8::StaticOrder, false>(lds, g, S, E, nullptr); }
    GRID_SYNC();

    { pg8::Gemm g{HID, W2OUT, MP, DM, DFF}; ReverseOrder S; S.init(MP, DM, nb, bid); EpiDown E{R, SUMSQ + 2 * MT}; pg8::gemm_phase<EpiDown, ReverseOrder, false>(lds, g, S, E, nullptr); }
    small_down<DFF>((LAS float*)lds, HID, W2OUT, R, SUMSQ + 2 * MT, bid, nb, tid, wid, lane);
    GRID_SYNC();

    row_phase<2, 4>(p, SUMSQ + 2 * MT, p.in[29], nullptr, RSTD + 2 * MT, 0, MT, gw, nw, lane);
}

extern "C" void kernel_launch(void* const* d_in, const int* in_sizes, int n_in, void* d_out, int out_size, void* d_ws, size_t ws_size, hipStream_t stream) {
    constexpr int LDS_BYTES = pg8::STAGE_BYTES;
    static int grid = 0;
    if (grid == 0) {
        if (n_in != 30 || ws_size < WS_END) { fprintf(stderr, "kernel_launch: expected 30 inputs and >= %zu bytes of workspace; got %d, %zu\n", (size_t)WS_END, n_in, ws_size); grid = -1; return; }
        int dev = 0, cus = 0, per_cu = 0;
        hipGetDevice(&dev); hipDeviceGetAttribute(&cus, hipDeviceAttributeMultiprocessorCount, dev);
        if (hipFuncSetAttribute((const void*)fwd_megakernel, hipFuncAttributeMaxDynamicSharedMemorySize, LDS_BYTES) != hipSuccess) { fprintf(stderr, "kernel_launch: hipFuncSetAttribute failed\n"); grid = -1; return; }
        if (hipOccupancyMaxActiveBlocksPerMultiprocessor(&per_cu, (const void*)fwd_megakernel, 512, LDS_BYTES) != hipSuccess || per_cu < 1) { fprintf(stderr, "kernel_launch: occupancy query says %d blocks per CU\n", per_cu); (void)hipGetLastError(); per_cu = 1; }
        grid = cus;
    }
    if (grid < 0) return;
    Params p{};
    for (int i = 0; i < 30; ++i) p.in[i] = (const float*)d_in[i];
    p.out = (float*)d_out; p.ws = (unsigned char*)d_ws;
    if (hipMemsetAsync((unsigned char*)d_ws + WS_BAR, 0, WS_BAR_BYTES, stream) != hipSuccess) { fprintf(stderr, "kernel_launch: hipMemsetAsync failed\n"); return; }
    void* args[] = {&p};
    hipError_t e = hipLaunchCooperativeKernel((const void*)fwd_megakernel, dim3(grid), dim3(512), args, LDS_BYTES, stream);
    if (e != hipSuccess) fprintf(stderr, "kernel_launch: cooperative launch failed: %s (grid %d)\n", hipGetErrorString(e), grid);
}
```

```cpp
#include <hip/hip_runtime.h>
#include <hip/hip_cooperative_groups.h>
#include <cstdio>
namespace pg8 {
#define PG8_LAS __attribute__((address_space(3)))
typedef unsigned short bf16_t;
typedef short bf16x8 __attribute__((ext_vector_type(8)));
typedef float f32x4 __attribute__((ext_vector_type(4)));
typedef unsigned u32x4 __attribute__((ext_vector_type(4)));
constexpr int BM = 256, BK = 64, HALF = 128, HTB = HALF * BK * 2  , STAGE_BYTES = 8 * HTB, NXCD = 8, WGM = 8;

__host__ __device__ __forceinline__ int lds_byte(int r, int c) { const int st = (r >> 4) * 2 + (c >> 5), rr = r & 15, cc = c & 31, ob = rr * 64 + cc * 2; return st * 1024 + (ob ^ (((ob >> 9) & 1) << 5)); }
__host__ __device__ __forceinline__ void stage_rc(int b, int& R, int& C) { const int st = b / 1024, sb = b % 1024, swz = sb ^ (((sb >> 9) & 1) << 5); R = (st >> 1) * 16 + swz / 64; C = (st & 1) * 32 + (swz % 64) / 2; }
__host__ __device__ __forceinline__ int perm32(int rho) { const int n = rho >> 4, i = rho & 15; return 8 * (i >> 2) + 4 * n + (i & 3); }

struct Unit { int pm, pn; };
struct Gemm { const bf16_t* A; const bf16_t* Bt; int M, N, K; };

struct StaticOrder {
    int nM, nN, nwg, G, c;
    __host__ __device__ void init(int M, int N, int G_, int c_) { nM = M / BM; nN = N / BM; nwg = nM * nN; G = G_; c = c_; }
    __host__ __device__ bool next(int i, Unit& u) const {
        const long L = (long)i * G + c; if (L >= nwg) return false;
        int wgid = (int)L; { const int q = nwg / NXCD, r = nwg % NXCD, xcd = wgid % NXCD, off = wgid / NXCD; wgid = (xcd < r ? xcd * (q + 1) : r * (q + 1) + (xcd - r) * q) + off; }
        const int nig = WGM * nN, gid = wgid / nig, fm = gid * WGM, gsz = (nM - fm) < WGM ? (nM - fm) : WGM;
        u.pm = fm + ((wgid % nig) % gsz); u.pn = (wgid % nig) / gsz; return true;
    }
    __device__ __forceinline__ void a_ready(const Unit&) const {}
    __device__ __forceinline__ void done(const Unit&) const {}
};
typedef float f32x2c __attribute__((ext_vector_type(2))); typedef __bf16 bf16x2c __attribute__((ext_vector_type(2)));
__device__ __forceinline__ unsigned cvt_pk_bf16(float lo, float hi) { const f32x2c f = {lo, hi}; const bf16x2c b = __builtin_convertvector(f, bf16x2c); return __builtin_bit_cast(unsigned, b); }
typedef float f32x2 __attribute__((ext_vector_type(2)));
template <class Epi, class Sched, bool STAMP = false>
__device__ __forceinline__ void gemm_phase(PG8_LAS unsigned char* lds, const Gemm g, const Sched& S, const Epi& E, unsigned long long* stamps) {
    int tid_; asm volatile("v_mov_b32 %0, %1" : "=v"(tid_) : "v"((int)threadIdx.x)); const int tid = tid_, wid = __builtin_amdgcn_readfirstlane(tid >> 6), lane = tid & 63, wr = wid >> 2, wc = wid & 3, fr = lane & 15, fq = lane >> 4;
    const int K = g.K, nt = K / BK;
    int ts_lo = 0, ts_hi = 0, nts = 0; const unsigned long long rt_entry = STAMP ? (unsigned long long)wall_clock64() : 0ull;
#define PG8_STAMP() do { if (STAMP && wid == 0 && nts < 64) { const unsigned long long _c = (unsigned long long)clock64(); \
        ts_lo = (lane == nts) ? (int)(unsigned)_c : ts_lo; ts_hi = (lane == nts) ? (int)(unsigned)(_c >> 32) : ts_hi; ++nts; } } while (0)
    PG8_STAMP();
    unsigned voffA[2], voffB[2];
#pragma unroll
    for (int i = 0; i < 2; ++i) { int R, C; stage_rc(tid * 16 + i * 8192, R, C); const int Rb = Epi::PERM ? ((R & ~31) + perm32(R & 31)) : R;
        voffA[i] = (unsigned)(R * K + C) * 2u; voffB[i] = (unsigned)(Rb * K + C) * 2u; }
    const size_t kstep = (size_t)(BK * 2);
    const size_t hstep = (size_t)HALF * K * 2;
    const size_t tstep = 2 * hstep;
    const unsigned ldsw = (unsigned)wid * 1024u;
    const int aoff = lds_byte(wr * 64 + fr, fq * 8), boff = lds_byte(wc * 32 + fr, fq * 8);
#define PG8_SA(b, h) (((b) * 2 + (h)) * HTB)
#define PG8_SB(b, h) ((4 + (b) * 2 + (h)) * HTB)
#define PG8_STAGE(bufoff, gbase, voff) do { _Pragma("unroll") for (int _i = 0; _i < 2; ++_i) \
        __builtin_amdgcn_global_load_lds((const unsigned*)((const char*)(gbase) + (voff)[_i]), (PG8_LAS unsigned*)(lds + (bufoff) + ldsw + _i * 8192), 16, 0, 0); } while (0)
#define PG8_LDA(dst, b, h) do { _Pragma("unroll") for (int m = 0; m < 4; ++m) _Pragma("unroll") for (int k = 0; k < 2; ++k) dst[m][k] = *(const PG8_LAS bf16x8*)(lds + PG8_SA(b, h) + aoff + m * 2048 + k * 1024); } while (0)
#define PG8_LDB(dst, b, h) do { _Pragma("unroll") for (int n = 0; n < 2; ++n) _Pragma("unroll") for (int k = 0; k < 2; ++k) dst[n][k] = *(const PG8_LAS bf16x8*)(lds + PG8_SB(b, h) + boff + n * 2048 + k * 1024); } while (0)
#define PG8_MMA(ai, bj, At, Bt) do { __builtin_amdgcn_s_setprio(1); _Pragma("unroll") for (int m = 0; m < 4; ++m) _Pragma("unroll") for (int n = 0; n < 2; ++n) _Pragma("unroll") for (int k = 0; k < 2; ++k) \
        acc[ai][bj][m][n] = __builtin_amdgcn_mfma_f32_16x16x32_bf16(Bt[n][k], At[m][k], acc[ai][bj][m][n], 0, 0, 0); __builtin_amdgcn_s_setprio(0); } while (0)
#define PG8_WAIT_V(n) asm volatile("s_waitcnt vmcnt(" #n ")" ::: "memory")
#define PG8_WAIT_L(n) asm volatile("s_waitcnt lgkmcnt(" #n ")" ::: "memory")
#define PG8_BAR __builtin_amdgcn_s_barrier()
#define PG8_SCHED __builtin_amdgcn_sched_barrier(0)
    Unit cur, nxt; int ui = 0;
    if (!S.next(0, cur)) return;
    f32x4 acc[2][2][4][2];
#pragma unroll
    for (int a = 0; a < 2; ++a)
#pragma unroll
        for (int b = 0; b < 2; ++b)
#pragma unroll
            for (int m = 0; m < 4; ++m)
#pragma unroll
                for (int n = 0; n < 2; ++n) acc[a][b][m][n] = (f32x4){0.f, 0.f, 0.f, 0.f};
    bf16x8 At[4][2], B0[2][2], B1[2][2];
    const char* cA = (const char*)g.A + (size_t)cur.pm * tstep; const char* cB = (const char*)g.Bt + (size_t)cur.pn * tstep;
    S.a_ready(cur);
    PG8_STAGE(PG8_SB(0, 0), cB, voffB); PG8_STAGE(PG8_SA(0, 0), cA, voffA); PG8_STAGE(PG8_SB(0, 1), cB + hstep, voffB); PG8_STAGE(PG8_SA(0, 1), cA + hstep, voffA);
    if (wr == 1) PG8_BAR;
    PG8_WAIT_V(4); PG8_BAR;
    PG8_STAGE(PG8_SB(1, 0), cB + kstep, voffB); PG8_STAGE(PG8_SA(1, 0), cA + kstep, voffA); PG8_STAGE(PG8_SB(1, 1), cB + hstep + kstep, voffB);
    PG8_WAIT_V(6); PG8_BAR;
    PG8_STAMP();
    for (;;) {
        const bool has_next = S.next(ui + 1, nxt);
        const char* nA = has_next ? (const char*)g.A + (size_t)nxt.pm * tstep : cA; const char* nB = has_next ? (const char*)g.Bt + (size_t)nxt.pn * tstep : cB;
        for (int t = 0; t < nt; t += 2) {
            const bool last = (t == nt - 2);
            const char* a1 = cA + (size_t)(t + 1) * kstep;
            const char* a2 = last ? nA : cA + (size_t)(t + 2) * kstep; const char* b2 = last ? nB : cB + (size_t)(t + 2) * kstep;
            const char* a3 = a2 + kstep; const char* b3 = b2 + kstep;
            if (last && has_next) S.a_ready(nxt);
            PG8_LDB(B0, 0, 0); PG8_SCHED; PG8_LDA(At, 0, 0); PG8_STAGE(PG8_SA(1, 1), a1 + hstep, voffA);
            PG8_WAIT_L(8); PG8_BAR; PG8_WAIT_L(0); PG8_MMA(0, 0, At, B0); PG8_BAR; PG8_SCHED;
            PG8_LDB(B1, 0, 1); PG8_STAGE(PG8_SB(0, 0), b2, voffB);
            PG8_BAR; PG8_WAIT_L(0); PG8_MMA(0, 1, At, B1); PG8_BAR;
            PG8_LDA(At, 0, 1); PG8_STAGE(PG8_SA(0, 0), a2, voffA);
            PG8_BAR; PG8_WAIT_L(0); PG8_MMA(1, 0, At, B0); PG8_BAR; PG8_SCHED;
            PG8_STAGE(PG8_SB(0, 1), b2 + hstep, voffB);
            PG8_WAIT_V(6); PG8_BAR; PG8_MMA(1, 1, At, B1); PG8_BAR;
            PG8_LDB(B0, 1, 0); PG8_SCHED; PG8_LDA(At, 1, 0); PG8_STAGE(PG8_SA(0, 1), a2 + hstep, voffA);
            PG8_WAIT_L(8); PG8_BAR; PG8_WAIT_L(0); PG8_MMA(0, 0, At, B0); PG8_BAR; PG8_SCHED;
            PG8_LDB(B1, 1, 1); PG8_STAGE(PG8_SB(1, 0), b3, voffB);
            PG8_BAR; PG8_WAIT_L(0); PG8_MMA(0, 1, At, B1); PG8_BAR;
            PG8_LDA(At, 1, 1); PG8_STAGE(PG8_SA(1, 0), a3, voffA);
            PG8_BAR; PG8_WAIT_L(0); PG8_MMA(1, 0, At, B0); PG8_BAR; PG8_SCHED;
            PG8_STAGE(PG8_SB(1, 1), b3 + hstep, voffB);
            PG8_WAIT_V(6); PG8_BAR; PG8_MMA(1, 1, At, B1); PG8_BAR;
        }
        PG8_STAMP();
        if constexpr (!Epi::AFTER_DRAIN) { E(acc, cur, wr, wc, fr, fq); S.done(cur); }
        PG8_STAMP();
        if (!has_next) break;
#pragma unroll
        for (int a = 0; a < 2; ++a)
#pragma unroll
            for (int b = 0; b < 2; ++b)
#pragma unroll
                for (int m = 0; m < 4; ++m)
#pragma unroll
                    for (int n = 0; n < 2; ++n) acc[a][b][m][n] = (f32x4){0.f, 0.f, 0.f, 0.f};
        cur = nxt; cA = nA; cB = nB; ++ui;
    }
    PG8_WAIT_V(0);
    if (wr == 0) PG8_BAR;
    PG8_BAR;
    if constexpr (Epi::AFTER_DRAIN) { E.fused(acc, cur, wr, wc, fr, fq, lds, wid, lane); S.done(cur); }
    PG8_STAMP();
    if (STAMP && wid == 0) { stamps[lane] = lane < nts ? (((unsigned long long)(unsigned)ts_hi << 32) | (unsigned)ts_lo) : 0ull;
        if (lane == 62) stamps[62] = rt_entry; if (lane == 63) stamps[63] = (unsigned long long)wall_clock64(); }
#undef PG8_STAMP
#undef PG8_SA
#undef PG8_SB
#undef PG8_STAGE
#undef PG8_LDA
#undef PG8_LDB
#undef PG8_MMA
#undef PG8_WAIT_V
#undef PG8_WAIT_L
#undef PG8_BAR
#undef PG8_SCHED
}
}

namespace cg = cooperative_groups;
using pg8::bf16_t; using pg8::bf16x8; using pg8::f32x4; using pg8::u32x4; using pg8::Unit; using pg8::cvt_pk_bf16;
typedef float f32x16 __attribute__((ext_vector_type(16)));
#define LAS PG8_LAS

constexpr int MP = 65536, MS = 512, MT = MP + MS;
constexpr int DM = 1024, DFF = 2816, NPROJ = 3072;
constexpr int NCR = 2064, CRP = 2304, KS = 640;
constexpr float EPS = 1e-6f;

constexpr size_t SZ_ACT = (size_t)MT * DM * 2;
constexpr size_t WS_XN = 0;
constexpr size_t WS_HID = WS_XN + SZ_ACT;
constexpr size_t SZ_HID = (size_t)MT * DFF * 2;
constexpr size_t WS_R = WS_HID + SZ_HID;
constexpr size_t WS_H = WS_R + SZ_ACT;
constexpr size_t WS_W1IN = WS_H + SZ_ACT;
constexpr size_t WS_W1OUT = WS_W1IN + (size_t)5632 * 1024 * 2;
constexpr size_t WS_WIN = WS_W1OUT + (size_t)1024 * 2816 * 2;
constexpr size_t WS_WGLU = WS_WIN + (size_t)3072 * 1024 * 2;
constexpr size_t WS_WPOOL = WS_WGLU + (size_t)2048 * 512 * 2;
constexpr size_t WS_WOUT = WS_WPOOL + (size_t)1024 * 512 * 2;
constexpr size_t WS_W2IN = WS_WOUT + (size_t)1024 * 1024 * 2;
constexpr size_t WS_W2OUT = WS_W2IN + (size_t)5632 * 1024 * 2;
constexpr size_t WS_SSMBT = WS_W2OUT + (size_t)1024 * 2816 * 2;
constexpr size_t WS_WEND = WS_SSMBT + (size_t)32 * 512 * KS * 2;
constexpr size_t WS_KLAG = WS_WEND + (size_t)32 * 128 * 512 * 2;
constexpr size_t WS_LP = WS_KLAG + (size_t)32 * 32 * 256 * 4;
constexpr size_t WS_BB = WS_LP + (size_t)32 * 33 * 64 * 8;
constexpr size_t WS_SUMSQ = WS_BB + (size_t)32 * 64 * 16 * 8;
constexpr size_t WS_FLAGS = WS_SUMSQ + (size_t)3 * MT * 4;
constexpr size_t WS_BAR = WS_FLAGS + 256;
constexpr size_t WS_BAR_BYTES = 24 * 256;
constexpr size_t WS_RSTD = WS_BAR + WS_BAR_BYTES;
constexpr size_t WS_UPD = (WS_RSTD + (size_t)3 * MT * 4 + 255) & ~(size_t)255;
constexpr size_t WS_END = WS_UPD + (size_t)MT * 512 * 2;
constexpr size_t WS_GATES = WS_HID;
constexpr size_t WS_POOLED = WS_HID + (size_t)MT * 2048 * 2;
constexpr size_t WS_UP = WS_UPD;
constexpr size_t WS_PM = WS_R;
constexpr size_t WS_E = WS_XN;
constexpr size_t WS_MERGED = WS_XN;
static_assert(WS_POOLED + (size_t)MT * 512 * 2 <= WS_R, "hid region overflow");
constexpr size_t DO_U = 0;
constexpr size_t DO_YG = (size_t)32 * CRP * KS * 2;
static_assert(DO_YG + (size_t)MT * 512 * 2 <= (size_t)MT * DM * 4, "d_out scratch overflow");
constexpr size_t OUT_Y = 0;
constexpr size_t OUT_RE_P = (size_t)MT * DM;
constexpr size_t OUT_IM_P = OUT_RE_P + 16384;
constexpr size_t OUT_POOL_P = OUT_IM_P + 16384;
constexpr size_t OUT_RE_S = OUT_POOL_P + 61440;
constexpr size_t OUT_IM_S = OUT_RE_S + 32768;
constexpr size_t OUT_POOL_S = OUT_IM_S + 32768;

struct Params { const float* in[30]; float* out; unsigned char* ws; };

__device__ __forceinline__ float bflo(unsigned w) { return __uint_as_float(w << 16); }
__device__ __forceinline__ float bfhi(unsigned w) { return __uint_as_float(w & 0xffff0000u); }
__device__ __forceinline__ float fast_sigmoid(float x) { return __builtin_amdgcn_rcpf(1.0f + __expf(-x)); }
__device__ __forceinline__ float wave_sum(float s) {
#pragma unroll
    for (int o = 32; o >= 1; o >>= 1) s += __shfl_xor(s, o);
    return s;
}
__device__ __forceinline__ void unpack8(const u32x4 w, float (&v)[8]) {
    v[0] = bflo(w.x); v[1] = bfhi(w.x); v[2] = bflo(w.y); v[3] = bfhi(w.y); v[4] = bflo(w.z); v[5] = bfhi(w.z); v[6] = bflo(w.w); v[7] = bfhi(w.w);
}
__device__ __forceinline__ u32x4 pack8(const float (&v)[8]) {
    u32x4 w; w.x = cvt_pk_bf16(v[0], v[1]); w.y = cvt_pk_bf16(v[2], v[3]); w.z = cvt_pk_bf16(v[4], v[5]); w.w = cvt_pk_bf16(v[6], v[7]); return w;
}

struct EpiFfnUp {
    static constexpr bool PERM = true, AFTER_DRAIN = false;
    bf16_t* O;
    __device__ __forceinline__ void operator()(const f32x4 (&acc)[2][2][4][2], const Unit& u, int wr, int wc, int fr, int fq) const {
        const int row0 = u.pm * 256 + wr * 64 + fr, col0 = u.pn * 128 + wc * 32 + 8 * fq;
#pragma unroll
        for (int ai = 0; ai < 2; ++ai)
#pragma unroll
            for (int m = 0; m < 4; ++m) {
                float v[8];
#pragma unroll
                for (int n = 0; n < 2; ++n)
#pragma unroll
                    for (int j = 0; j < 4; ++j) { const float a = acc[ai][0][m][n][j], b = acc[ai][1][m][n][j]; v[n * 4 + j] = a * fast_sigmoid(a) * b; }
                *(u32x4*)(O + (size_t)(row0 + ai * 128 + m * 16) * DFF + col0) = pack8(v);
            }
    }
};
struct EpiDown {
    static constexpr bool PERM = true, AFTER_DRAIN = false;
    bf16_t* O; float* sumsq;
    __device__ __forceinline__ void operator()(const f32x4 (&acc)[2][2][4][2], const Unit& u, int wr, int wc, int fr, int fq) const {
        const int row0 = u.pm * 256 + wr * 64 + fr, col0 = u.pn * 256 + wc * 32 + 8 * fq;
#pragma unroll
        for (int ai = 0; ai < 2; ++ai)
#pragma unroll
            for (int m = 0; m < 4; ++m) {
                const int row = row0 + ai * 128 + m * 16; float s = 0.f;
#pragma unroll
                for (int bj = 0; bj < 2; ++bj) {
                    float v[8];
#pragma unroll
                    for (int n = 0; n < 2; ++n)
#pragma unroll
                        for (int j = 0; j < 4; ++j) { const float a = acc[ai][bj][m][n][j]; v[n * 4 + j] = a; s += a * a; }
                    *(u32x4*)(O + (size_t)row * DM + col0 + bj * 128) = pack8(v);
                }
                s += __shfl_xor(s, 16); s += __shfl_xor(s, 32);
                if (fq == 0) atomicAdd(sumsq + row, s);
            }
    }
};
struct EpiInProj {
    static constexpr bool PERM = true, AFTER_DRAIN = false;
    bf16_t* U; bf16_t* UP; bf16_t* GT; const float* bias; float* out; const float* rs;
    __device__ __forceinline__ void operator()(const f32x4 (&acc)[2][2][4][2], const Unit& u, int wr, int wc, int fr, int fq) const {
        const int row0 = u.pm * 256 + wr * 64 + fr;
#pragma unroll
        for (int bj = 0; bj < 2; ++bj) {
            const int col = u.pn * 256 + bj * 128 + wc * 32 + 8 * fq;
            const f32x4 b0 = *(const f32x4*)(bias + col), b1 = *(const f32x4*)(bias + col + 4);
#pragma unroll
            for (int ai = 0; ai < 2; ++ai)
#pragma unroll
                for (int m = 0; m < 4; ++m) {
                    const int row = row0 + ai * 128 + m * 16; const float r = rs[row];
                    float v[8];
#pragma unroll
                    for (int j = 0; j < 4; ++j) { v[j] = acc[ai][bj][m][0][j] * r + b0[j]; v[4 + j] = acc[ai][bj][m][1][j] * r + b1[j]; }
                    if (u.pn < 2) {
                        const int g = col >> 4, cc = col & 15, cr = row >> 5, t = row & 31;
                        *(u32x4*)(U + ((size_t)(g * CRP + cr) * KS + t * 16 + cc)) = pack8(v);
                    } else if (u.pn < 4) {
                        const int c = col - 512;
                        *(u32x4*)(UP + (size_t)row * 512 + c) = pack8(v);
                        int hr = -1; size_t ob = 0;
                        if (row < MP) { const int tt = row & 8191; if (tt >= 8177) { hr = tt - 8177; ob = OUT_POOL_P + (size_t)((row >> 13) * 15 + hr) * 512; } }
                        else { const int tt = row & 31; if (tt >= 17) { hr = tt - 17; ob = OUT_POOL_S + (size_t)(((row - MP) >> 5) * 15 + hr) * 512; } }
                        if (hr >= 0) { *(f32x4*)(out + ob + c) = (f32x4){v[0], v[1], v[2], v[3]}; *(f32x4*)(out + ob + c + 4) = (f32x4){v[4], v[5], v[6], v[7]}; }
                    } else {
#pragma unroll
                        for (int j = 0; j < 8; ++j) v[j] = fast_sigmoid(v[j]);
                        *(u32x4*)(GT + (size_t)row * 2048 + (col - 1024)) = pack8(v);
                    }
                }
        }
    }
};
struct EpiSsm {
    static constexpr bool PERM = true, AFTER_DRAIN = false;
    const bf16_t* U; bf16_t* YG; const float* dskip;
    __device__ __forceinline__ void operator()(const f32x4 (&acc)[2][2][4][2], const Unit& u, int wr, int wc, int fr, int fq) const {
        const int g = u.pn >> 1, cr0 = (u.pm - 9 * g) * 256 + wr * 64 + fr;
#pragma unroll
        for (int bj = 0; bj < 2; ++bj) {
            const int col = (u.pn & 1) * 256 + bj * 128 + wc * 32 + 8 * fq, t = col >> 4, cc = col & 15, ch = g * 16 + cc;
            const f32x4 d0 = *(const f32x4*)(dskip + ch), d1 = *(const f32x4*)(dskip + ch + 4);
#pragma unroll
            for (int ai = 0; ai < 2; ++ai)
#pragma unroll
                for (int m = 0; m < 4; ++m) {
                    const int cr = cr0 + ai * 128 + m * 16;
                    if (cr < NCR) {
                        const u32x4 uw = *(const u32x4*)(U + ((size_t)(g * CRP + cr) * KS + col));
                        float uu[8], v[8]; unpack8(uw, uu);
#pragma unroll
                        for (int j = 0; j < 4; ++j) { v[j] = acc[ai][bj][m][0][j] + d0[j] * uu[j]; v[4 + j] = acc[ai][bj][m][1][j] + d1[j] * uu[4 + j]; }
#pragma unroll
                        for (int j = 0; j < 8; ++j) { const float x = v[j]; v[j] = x * fast_sigmoid(1.5957691216f * (x + 0.044715f * x * x * x)); }
                        *(u32x4*)(YG + (size_t)(cr * 32 + t) * 512 + ch) = pack8(v);
                    }
                }
        }
    }
};
struct EpiPool {
    static constexpr bool PERM = true, AFTER_DRAIN = false;
    const bf16_t* GT; bf16_t* PM;
    __device__ __forceinline__ void operator()(const f32x4 (&acc)[2][2][4][2], const Unit& u, int wr, int wc, int fr, int fq) const {
        const int row0 = (u.pm % 258) * 256 + wr * 64 + fr, col0 = u.pn * 256 + wc * 32 + 8 * fq;
#pragma unroll
        for (int ai = 0; ai < 2; ++ai)
#pragma unroll
            for (int m = 0; m < 4; ++m) {
                const int row = row0 + ai * 128 + m * 16;
#pragma unroll
                for (int bj = 0; bj < 2; ++bj) {
                    const int col = col0 + bj * 128;
                    const u32x4 gw = *(const u32x4*)(GT + (size_t)row * 2048 + 1024 + col);
                    float gg[8], v[8]; unpack8(gw, gg);
#pragma unroll
                    for (int j = 0; j < 4; ++j) { v[j] = acc[ai][bj][m][0][j] * gg[j]; v[4 + j] = acc[ai][bj][m][1][j] * gg[4 + j]; }
                    *(u32x4*)(PM + (size_t)row * DM + col) = pack8(v);
                }
            }
    }
};
struct EpiGlu {
    static constexpr bool PERM = true, AFTER_DRAIN = false;
    const bf16_t* GT; const bf16_t* PM; bf16_t* MG; const float* bias;
    __device__ __forceinline__ void operator()(const f32x4 (&acc)[2][2][4][2], const Unit& u, int wr, int wc, int fr, int fq) const {
        const int row0 = u.pm * 256 + wr * 64 + fr, col = u.pn * 128 + wc * 32 + 8 * fq;
        const f32x4 ba0 = *(const f32x4*)(bias + col), ba1 = *(const f32x4*)(bias + col + 4), bg0 = *(const f32x4*)(bias + 1024 + col), bg1 = *(const f32x4*)(bias + 1024 + col + 4);
#pragma unroll
        for (int ai = 0; ai < 2; ++ai)
#pragma unroll
            for (int m = 0; m < 4; ++m) {
                const int row = row0 + ai * 128 + m * 16;
                const u32x4 gw = *(const u32x4*)(GT + (size_t)row * 2048 + col), pw = *(const u32x4*)(PM + (size_t)row * DM + col);
                float gs[8], pm[8], v[8]; unpack8(gw, gs); unpack8(pw, pm);
#pragma unroll
                for (int j = 0; j < 4; ++j) {
                    v[j] = gs[j] * ((acc[ai][0][m][0][j] + ba0[j]) * fast_sigmoid(acc[ai][1][m][0][j] + bg0[j])) + pm[j];
                    v[4 + j] = gs[4 + j] * ((acc[ai][0][m][1][j] + ba1[j]) * fast_sigmoid(acc[ai][1][m][1][j] + bg1[j])) + pm[4 + j];
                }
                *(u32x4*)(MG + (size_t)row * DM + col) = pack8(v);
            }
    }
};
struct GroupOrder {
    int G, c;
    __device__ __forceinline__ bool next(int i, Unit& u) const { const int L = i * G + c; if (L >= 512) return false; const int g = L >> 4, r = L & 15; u.pm = g * 9 + (r >> 1); u.pn = g * 2 + (r & 1); return true; }
    __device__ __forceinline__ void a_ready(const Unit&) const {}
    __device__ __forceinline__ void done(const Unit&) const {}
};

struct PoolOrder {
    int G, c;
    __device__ __forceinline__ bool next(int i, Unit& u) const { const int L = i * G + c; if (L >= 258 * 4) return false; const int pn = L & 3, pm = L >> 2; u.pm = (pn >> 1) * 258 + pm; u.pn = pn; return true; }
    __device__ __forceinline__ void a_ready(const Unit&) const {}
    __device__ __forceinline__ void done(const Unit&) const {}
};
template <int K, int NOUT, int MODE, int HO>
__device__ __forceinline__ void conv_weight(LAS float* tile, const float* __restrict__ W, bf16_t* __restrict__ Wt, const float* __restrict__ rowg, int tid, int bid, int nb) {
    constexpr int TK = K / 64, TS = NOUT / 256;
    const int kr = tid >> 4, nc = (tid & 15) * 4;
    for (int t = bid; t < TK * TS; t += nb) {
        const int kt = t % TK, ns = t / TK, k0 = kt * 64;
        f32x4 v[4][2];
#pragma unroll
        for (int s4 = 0; s4 < 4; ++s4) {
            const int s0 = (MODE == 1) ? ((s4 >> 1) * HO + 128 * ns + (s4 & 1) * 64) : (ns * 256 + s4 * 64);
#pragma unroll
            for (int p = 0; p < 2; ++p) v[s4][p] = *(const f32x4*)(W + (size_t)(k0 + kr + 32 * p) * NOUT + s0 + nc);
        }
        const float g0 = rowg ? rowg[k0 + kr] : 1.0f, g1 = rowg ? rowg[k0 + kr + 32] : 1.0f;
#pragma unroll
        for (int s4 = 0; s4 < 4; ++s4)
#pragma unroll
            for (int p = 0; p < 2; ++p) { const float gk = p ? g1 : g0; LAS float* tp = tile + s4 * 4160 + (kr + 32 * p) * 65 + nc;
                tp[0] = v[s4][p][0] * gk; tp[1] = v[s4][p][1] * gk; tp[2] = v[s4][p][2] * gk; tp[3] = v[s4][p][3] * gk; }
        __syncthreads();
        const int n = tid >> 3, k8 = (tid & 7) * 8;
#pragma unroll
        for (int s4 = 0; s4 < 4; ++s4) {
            float o[8];
#pragma unroll
            for (int i = 0; i < 8; ++i) o[i] = tile[s4 * 4160 + (k8 + i) * 65 + n];
            *(u32x4*)(Wt + (size_t)(ns * 256 + s4 * 64 + n) * K + k0 + k8) = pack8(o);
        }
        __syncthreads();
    }
}

template <int MODE, int NR>
__device__ __forceinline__ void row_phase(const Params& p, const float* __restrict__ sumsq, const float* __restrict__ gain, float* __restrict__ rstd_out, const float* __restrict__ rstd0, const int rbeg, const int rend, int gw, int nw, int lane) {
    const bf16_t* R = (const bf16_t*)(p.ws + WS_R); bf16_t* H = (bf16_t*)(p.ws + WS_H); bf16_t* XNo = (bf16_t*)(p.ws + WS_XN);
    const bf16_t* B = (MODE == 1) ? (const bf16_t*)H : (const bf16_t*)(p.ws + WS_XN);
    const float scale = (MODE == 1) ? 1.0f : 0.5f;
    float g[2][8];
#pragma unroll
    for (int i = 0; i < 2; ++i) { const f32x4 a = *(const f32x4*)(gain + i * 512 + lane * 8), b = *(const f32x4*)(gain + i * 512 + lane * 8 + 4);
#pragma unroll
        for (int j = 0; j < 4; ++j) { g[i][j] = a[j] * scale; g[i][4 + j] = b[j] * scale; } }
    for (int row0 = rbeg + gw; row0 < rend; row0 += NR * nw) {
        u32x4 rw[NR][2], hw[NR][2]; float sq[NR], bs[NR];
#pragma unroll
        for (int q = 0; q < NR; ++q) {
            const int row = (row0 + q * nw < rend) ? row0 + q * nw : row0;
            sq[q] = sumsq[row]; bs[q] = (MODE != 1) ? rstd0[row] : 1.0f;
#pragma unroll
            for (int i = 0; i < 2; ++i) { const size_t off = (size_t)row * DM + i * 512 + lane * 8; rw[q][i] = __builtin_nontemporal_load((const u32x4*)(R + off)); hw[q][i] = __builtin_nontemporal_load((const u32x4*)(B + off)); }
        }
#pragma unroll
        for (int q = 0; q < NR; ++q) {
            const int row = row0 + q * nw;
            if (row >= rend) break;
            const float rstd = rsqrtf(sq[q] * (1.0f / 1024.0f) + EPS);
            const float binv = (MODE != 1) ? 1.0f / bs[q] : 1.0f;
            float ss = 0.f; float hk[2][8];
#pragma unroll
            for (int i = 0; i < 2; ++i) {
                const size_t off = (size_t)row * DM + i * 512 + lane * 8;
                float r[8], b[8]; float (&h)[8] = hk[i]; unpack8(rw[q][i], r); unpack8(hw[q][i], b);
#pragma unroll
                for (int j = 0; j < 8; ++j) { h[j] = b[j] * binv + r[j] * rstd * g[i][j]; ss += h[j] * h[j]; }
                if (MODE == 2) { float* o = p.out + OUT_Y + off; __builtin_nontemporal_store((f32x4){h[0], h[1], h[2], h[3]}, (f32x4*)o); __builtin_nontemporal_store((f32x4){h[4], h[5], h[6], h[7]}, (f32x4*)(o + 4)); }
                else if (MODE == 0) *(u32x4*)(H + off) = pack8(h);
            }
            if (MODE != 2) { ss = wave_sum(ss); const float rs = rsqrtf(ss * (1.0f / 1024.0f) + EPS);
                if (lane == 0) rstd_out[row] = rs;
                if (MODE == 1) {
#pragma unroll
                    for (int i = 0; i < 2; ++i) { float z[8];
#pragma unroll
                        for (int j = 0; j < 8; ++j) z[j] = hk[i][j] * rs;
                        *(u32x4*)(XNo + (size_t)row * DM + i * 512 + lane * 8) = pack8(z); } } }
        }
    }
}

template <int K>
__device__ __forceinline__ void small_down(LAS float* red, const bf16_t* __restrict__ A, const bf16_t* __restrict__ Bt, bf16_t* __restrict__ O, float* sumsq, int bid, int nb, int tid, int wid, int lane) {
    constexpr int KW = K / 8;
    for (int task = bid; task < 256; task += nb) {
        const int rb = task >> 4, cb = task & 15;
        const bf16_t* Ap = A + (size_t)(MP + rb * 32 + (lane & 31)) * K + wid * KW + 8 * (lane >> 5);
        const bf16_t* Bp = Bt + (size_t)(cb * 64 + (lane & 31)) * K + wid * KW + 8 * (lane >> 5);
        f32x16 acc0, acc1;
#pragma unroll
        for (int j = 0; j < 16; ++j) { acc0[j] = 0.f; acc1[j] = 0.f; }
#pragma unroll 4
        for (int k0 = 0; k0 < KW; k0 += 16) {
            const bf16x8 a = *(const bf16x8*)(Ap + k0), b0 = *(const bf16x8*)(Bp + k0), b1 = *(const bf16x8*)(Bp + (size_t)32 * K + k0);
            acc0 = __builtin_amdgcn_mfma_f32_32x32x16_bf16(a, b0, acc0, 0, 0, 0); acc1 = __builtin_amdgcn_mfma_f32_32x32x16_bf16(a, b1, acc1, 0, 0, 0);
        }
#pragma unroll
        for (int j = 0; j < 16; ++j) { red[((wid * 2 + 0) * 16 + j) * 64 + lane] = acc0[j]; red[((wid * 2 + 1) * 16 + j) * 64 + lane] = acc1[j]; }
        __syncthreads();
#pragma unroll
        for (int i = 0; i < 4; ++i) {
            const int idx = tid + 512 * i; float s = 0.f;
#pragma unroll
            for (int w = 0; w < 8; ++w) s += red[w * 2048 + idx];
            const int q = idx >> 10, j = (idx >> 6) & 15;
            const int row = MP + rb * 32 + (j & 3) + 8 * (j >> 2) + 4 * (lane >> 5), col = cb * 64 + 32 * q + (lane & 31);
            O[(size_t)row * DM + col] = (bf16_t)(cvt_pk_bf16(s, 0.f) & 0xffffu);
            float sq = s * s;
            sq += __shfl_xor(sq, 16); sq += __shfl_xor(sq, 8); sq += __shfl_xor(sq, 4); sq += __shfl_xor(sq, 2); sq += __shfl_xor(sq, 1);
            if ((lane & 31) == 0) atomicAdd(sumsq + row, sq);
        }
        __syncthreads();
    }
}


__device__ __forceinline__ void small_ssm(const bf16_t* __restrict__ U, const bf16_t* __restrict__ Bt, bf16_t* __restrict__ YG, const float* __restrict__ dskip, int gw, int nw, int lane) {
    for (int task = gw; task < 32 * 16; task += nw) {
        const int g = task >> 4, cb = task & 15;
        const bf16_t* Ap = U + (size_t)(g * CRP + 2048 + (lane & 31)) * KS + 8 * (lane >> 5);
        const bf16_t* Bp = Bt + (size_t)(g * 512 + cb * 32 + (lane & 31)) * KS + 8 * (lane >> 5);
        f32x16 acc;
#pragma unroll
        for (int j = 0; j < 16; ++j) acc[j] = 0.f;
#pragma unroll 8
        for (int k0 = 0; k0 < KS; k0 += 16) { const bf16x8 a = *(const bf16x8*)(Ap + k0), b = *(const bf16x8*)(Bp + k0); acc = __builtin_amdgcn_mfma_f32_32x32x16_bf16(a, b, acc, 0, 0, 0); }
        const int col = cb * 32 + (lane & 31), t = col >> 4, c = col & 15; const float d = dskip[g * 16 + c];
#pragma unroll
        for (int j = 0; j < 8; ++j) {
            const int cr = 2048 + (j & 3) + 8 * (j >> 2) + 4 * (lane >> 5);
            const float uu = __uint_as_float((unsigned)U[(size_t)(g * CRP + cr) * KS + col] << 16);
            const float x = acc[j] + d * uu, v = x * fast_sigmoid(1.5957691216f * (x + 0.044715f * x * x * x));
            YG[(size_t)(cr * 32 + t) * 512 + g * 16 + c] = (bf16_t)(cvt_pk_bf16(v, 0.f) & 0xffffu);
        }
    }
}

__device__ __forceinline__ void grid_barrier(unsigned* bar, unsigned epoch, int bid, int nb, int tid) {
    asm volatile("s_waitcnt vmcnt(0) lgkmcnt(0)" ::: "memory");
    __syncthreads();
    if (tid == 0) {
        __builtin_amdgcn_fence(__ATOMIC_RELEASE, "agent"); asm volatile("s_waitcnt vmcnt(0)" ::: "memory");
        const int j = bid & 7; const unsigned ng = (unsigned)((nb - j + 7) >> 3);
        const unsigned old = __hip_atomic_fetch_add(bar + 64 * j, 1u, __ATOMIC_RELAXED, __HIP_MEMORY_SCOPE_AGENT);
        if (old == ng * epoch - 1u) {
            const unsigned ngroups = (unsigned)(nb < 8 ? nb : 8);
            const unsigned oldt = __hip_atomic_fetch_add(bar + 64 * 8, 1u, __ATOMIC_RELAXED, __HIP_MEMORY_SCOPE_AGENT);
            if (oldt == ngroups * epoch - 1u) {
#pragma unroll
                for (int q = 0; q < 8; ++q) __hip_atomic_store(bar + 64 * (9 + q), epoch, __ATOMIC_RELAXED, __HIP_MEMORY_SCOPE_AGENT);
            }
        }
        unsigned spins = 0;
        while (__hip_atomic_load(bar + 64 * (9 + j), __ATOMIC_RELAXED, __HIP_MEMORY_SCOPE_AGENT) < epoch) { __builtin_amdgcn_s_sleep(1); if (++spins > (1u << 24)) break; }
        __builtin_amdgcn_fence(__ATOMIC_ACQUIRE, "agent"); asm volatile("s_waitcnt vmcnt(0)" ::: "memory");
    }
    __syncthreads();
}

__device__ __forceinline__ void p0_xn(const Params& p, bf16_t* __restrict__ XN, float* __restrict__ RSTD, const int rbeg, const int rend, const int gw, const int nw, const int lane) {
        for (int row0 = rbeg + gw; row0 < rend; row0 += 2 * nw) {
            const bool two = (row0 + nw) < rend;
            f32x4 v[2][4];
#pragma unroll
            for (int q = 0; q < 2; ++q) { const int row = (q == 0 || two) ? row0 + q * nw : row0;
                const float* xr = (row < MP) ? (p.in[0] + (size_t)row * DM) : (p.in[1] + (size_t)(row - MP) * DM);
#pragma unroll
                for (int i = 0; i < 4; ++i) v[q][i] = __builtin_nontemporal_load((const f32x4*)(xr + i * 256 + lane * 4)); }
#pragma unroll
            for (int q = 0; q < 2; ++q) {
                if (q == 1 && !two) break;
                const int row = row0 + q * nw; float ss = 0.f;
#pragma unroll
                for (int i = 0; i < 4; ++i) ss += v[q][i][0] * v[q][i][0] + v[q][i][1] * v[q][i][1] + v[q][i][2] * v[q][i][2] + v[q][i][3] * v[q][i][3];
                ss = wave_sum(ss);
                const float rs = rsqrtf(ss * (1.0f / 1024.0f) + EPS);
                if (lane == 0) RSTD[row] = rs;
#pragma unroll
                for (int i = 0; i < 4; ++i) { typedef unsigned u32x2 __attribute__((ext_vector_type(2))); u32x2 w; w.x = cvt_pk_bf16(v[q][i][0] * rs, v[q][i][1] * rs); w.y = cvt_pk_bf16(v[q][i][2] * rs, v[q][i][3] * rs);
                    *(u32x2*)(XN + (size_t)row * DM + i * 256 + lane * 4) = w; }
            }
        }
}

__device__ __forceinline__ void sub_barrier(unsigned* word, unsigned count, int tid) {
    asm volatile("s_waitcnt vmcnt(0) lgkmcnt(0)" ::: "memory");
    __syncthreads();
    if (tid == 0) {
        __builtin_amdgcn_fence(__ATOMIC_RELEASE, "agent"); asm volatile("s_waitcnt vmcnt(0)" ::: "memory");
        __hip_atomic_fetch_add(word, 1u, __ATOMIC_RELAXED, __HIP_MEMORY_SCOPE_AGENT);
        unsigned spins = 0;
        while (__hip_atomic_load(word, __ATOMIC_RELAXED, __HIP_MEMORY_SCOPE_AGENT) < count) { __builtin_amdgcn_s_sleep(1); if (++spins > (1u << 24)) break; }
        __builtin_amdgcn_fence(__ATOMIC_ACQUIRE, "agent"); asm volatile("s_waitcnt vmcnt(0)" ::: "memory");
    }
    __syncthreads();
}
struct OneUnit {
    int pm, pn;
    __device__ __forceinline__ bool next(int i, Unit& u) const { if (i != 0) return false; u.pm = pm; u.pn = pn; return true; }
    __device__ __forceinline__ void a_ready(const Unit&) const {}
    __device__ __forceinline__ void done(const Unit&) const {}
};
#define GRID_SYNC() grid_barrier((unsigned*)(ws + WS_BAR), ++epoch, bid, nb, tid)
#define GRID_SYNC_CG() do { asm volatile("s_waitcnt vmcnt(0) lgkmcnt(0)" ::: "memory"); __syncthreads(); if (wid == 0) { __builtin_amdgcn_fence(__ATOMIC_RELEASE, "agent"); asm volatile("s_waitcnt vmcnt(0)" ::: "memory"); } grid.sync(); __builtin_amdgcn_fence(__ATOMIC_ACQUIRE, "agent"); asm volatile("s_waitcnt vmcnt(0)" ::: "memory"); } while (0)
__device__ __forceinline__ void pooled_row(float (&v)[8], int tt, int r0, int oct, int pos0, bool smp, const bf16_t* __restrict__ UP, const float* __restrict__ cache) {
    if (tt >= 0 || (!smp && pos0 + tt >= 0)) unpack8(*(const u32x4*)(UP + (size_t)(r0 + tt) * 512 + oct * 8), v);
    else if (smp) { const f32x4 a = *(const f32x4*)(cache + (size_t)(15 + tt) * 512), b = *(const f32x4*)(cache + (size_t)(15 + tt) * 512 + 4);
#pragma unroll
        for (int j = 0; j < 4; ++j) { v[j] = a[j]; v[4 + j] = b[j]; } }
    else {
#pragma unroll
        for (int j = 0; j < 8; ++j) v[j] = 0.f; }
}
__device__ __forceinline__ void pooled_task(const int i, const int tb, const int nrows, const bf16_t* __restrict__ UP, bf16_t* __restrict__ POOLED, const Params& p) {
    const int oct = i & 63, cr = i >> 6, gi = oct >> 4, w = 2 << gi, r0 = cr * 32;
    const bool smp = cr >= 2048; const int pos0 = smp ? 2048 : (cr & 255) * 32;
    const float* cache = p.in[4] + (size_t)(cr - 2048) * 15 * 512 + oct * 8;
    float S[8];
#pragma unroll
    for (int j = 0; j < 8; ++j) S[j] = 0.f;
    for (int tt = tb + 1 - w; tt < tb; ++tt) {
        float v[8]; pooled_row(v, tt, r0, oct, pos0, smp, UP, cache);
#pragma unroll
        for (int j = 0; j < 8; ++j) S[j] += v[j];
    }
    for (int t0 = tb; t0 < tb + nrows; t0 += 8) {
        float cur[8][8], old[8][8];
#pragma unroll
        for (int q = 0; q < 8; ++q) { pooled_row(cur[q], t0 + q, r0, oct, pos0, smp, UP, cache);
            if (t0 + q > tb) pooled_row(old[q], t0 + q - w, r0, oct, pos0, smp, UP, cache);
            else {
#pragma unroll
                for (int j = 0; j < 8; ++j) old[q][j] = 0.f; } }
#pragma unroll
        for (int q = 0; q < 8; ++q) {
            const int pos = pos0 + t0 + q; const float inv = 1.0f / (float)((pos + 1 < w) ? (pos + 1) : w);
            float o[8];
#pragma unroll
            for (int j = 0; j < 8; ++j) { S[j] += cur[q][j] - old[q][j]; o[j] = S[j] * inv - cur[q][j]; }
            *(u32x4*)(POOLED + ((size_t)(oct >> 5) * MT + (size_t)(r0 + t0 + q)) * 256 + (oct & 31) * 8) = pack8(o);
        }
    }
}
#define POOLED_TASK(i) pooled_task((i), 0, 32, UP, POOLED, p)
__global__ void __launch_bounds__(512) fwd_megakernel(Params p) {
    extern __shared__ __attribute__((aligned(16))) unsigned char shm[];
    cg::grid_group grid = cg::this_grid();
    LAS unsigned char* lds = (LAS unsigned char*)shm;
    const int tid = threadIdx.x, lane = tid & 63, wid = __builtin_amdgcn_readfirstlane(tid >> 6);
    const int bid = blockIdx.x, nb = gridDim.x, gw = bid * 8 + wid, nw = nb * 8, gt = bid * 512 + tid, nt = nb * 512;
    unsigned char* ws = p.ws; unsigned char* dob = (unsigned char*)p.out; unsigned epoch = 0u;
    bf16_t* XN = (bf16_t*)(ws + WS_XN); bf16_t* HID = (bf16_t*)(ws + WS_HID); bf16_t* R = (bf16_t*)(ws + WS_R);
    bf16_t* GATES = (bf16_t*)(ws + WS_GATES); bf16_t* POOLED = (bf16_t*)(ws + WS_POOLED); bf16_t* UP = (bf16_t*)(ws + WS_UP); bf16_t* PMb = (bf16_t*)(ws + WS_PM);
    bf16_t* MERGED = (bf16_t*)(ws + WS_MERGED); float* Eb = (float*)(ws + WS_E);
    bf16_t* Uq = (bf16_t*)(dob + DO_U); bf16_t* YG = (bf16_t*)(dob + DO_YG);
    bf16_t* W1IN = (bf16_t*)(ws + WS_W1IN); bf16_t* W1OUT = (bf16_t*)(ws + WS_W1OUT); bf16_t* WIN = (bf16_t*)(ws + WS_WIN); bf16_t* WGLU = (bf16_t*)(ws + WS_WGLU);
    bf16_t* WPOOL = (bf16_t*)(ws + WS_WPOOL); bf16_t* WOUT = (bf16_t*)(ws + WS_WOUT); bf16_t* W2IN = (bf16_t*)(ws + WS_W2IN); bf16_t* W2OUT = (bf16_t*)(ws + WS_W2OUT);
    bf16_t* SSMBT = (bf16_t*)(ws + WS_SSMBT); bf16_t* WEND = (bf16_t*)(ws + WS_WEND);
    float* RSTD = (float*)(ws + WS_RSTD); bf16_t* Hb = (bf16_t*)(ws + WS_H);
    float* KLAG = (float*)(ws + WS_KLAG); float* LP = (float*)(ws + WS_LP); float* BB = (float*)(ws + WS_BB); float* SUMSQ = (float*)(ws + WS_SUMSQ);

    {
        {
            constexpr int NS1 = 44;
            LAS float* tile = (LAS float*)lds;
            if (bid < NS1) {
                conv_weight<1024, 5632, 1, 2816>(tile, p.in[6], W1IN, p.in[5], tid, bid, NS1);
                p0_xn(p, XN, RSTD, MP, MT, bid * 8 + wid, NS1 * 8, lane);
                sub_barrier((unsigned*)(ws + WS_BAR) + 64 * 19, NS1, tid);
                { pg8::Gemm g{XN, W1IN, MT, 2 * DFF, DM}; OneUnit S{256 + bid / 22, bid % 22}; EpiFfnUp E{HID}; pg8::gemm_phase<EpiFfnUp, OneUnit, false>(lds, g, S, E, nullptr); }
                conv_weight<2816, 1024, 0, 0>(tile, p.in[7], W1OUT, nullptr, tid, bid, NS1);
            } else {
                conv_weight<1024, 3072, 0, 0>(tile, p.in[10], WIN, p.in[9], tid, bid - NS1, nb - NS1);
                p0_xn(p, XN, RSTD, 0, MP, (bid - NS1) * 8 + wid, (nb - NS1) * 8, lane);
            }
        }
        for (int i = gt; i < 1024 * 32; i += nt) {
            const int n = i >> 5, k8 = (i & 31) * 8, gi = n >> 8, ch = (gi >> 1) * 256 + k8; float v[8];
#pragma unroll
            for (int j = 0; j < 8; ++j) v[j] = 0.f;
            if ((ch >> 7) == gi) { const float sc = p.in[23][n];
#pragma unroll
                for (int j = 0; j < 8; ++j) v[j] = p.in[22][(size_t)gi * 32768 + (size_t)((ch & 127) + j) * 256 + (n & 255)] * sc; }
            *(u32x4*)(WPOOL + (size_t)n * 256 + k8) = pack8(v);
        }
        for (int i = gt; i < 32 * 33 * 64; i += nt) {
            const int pp = i & 63, j = (i >> 6) % 33, g = i / (33 * 64);
            const float dt = expf(p.in[14][g]), lr = p.in[12][g * 64 + pp], li = p.in[13][g * 64 + pp];
            const float mag = expf((float)j * lr * dt);
            const double turns = (double)j * ((double)li * (double)dt) * 0.15915494309189533577;
            const float fr = (float)(turns - rint(turns));
            LP[(size_t)i * 2] = mag * __builtin_amdgcn_cosf(fr); LP[(size_t)i * 2 + 1] = mag * __builtin_amdgcn_sinf(fr);
        }
        for (int i = gt; i < 32 * 64; i += nt) {
            const int pp = i & 63, g = i >> 6;
            const float dt = expf(p.in[14][g]), lr = p.in[12][i], li = p.in[13][i];
            const float mag = expf(lr * dt);
            const double turns = ((double)li * (double)dt) * 0.15915494309189533577;
            const float fr = (float)(turns - rint(turns));
            const float abr = mag * __builtin_amdgcn_cosf(fr), abi = mag * __builtin_amdgcn_sinf(fr);
            const float den = lr * lr + li * li, nr = abr - 1.0f;
            const float fre = (nr * lr + abi * li) / den, fim = (abi * lr - nr * li) / den;
#pragma unroll
            for (int c = 0; c < 16; ++c) { const float br = p.in[15][(size_t)i * 16 + c], bi = p.in[16][(size_t)i * 16 + c];
                BB[((size_t)i * 16 + c) * 2] = fre * br - fim * bi; BB[((size_t)i * 16 + c) * 2 + 1] = fre * bi + fim * br; }
            (void)pp;
        }
        for (int i = gt; i < 3 * MT; i += nt) SUMSQ[i] = 0.f;
        if (gt < 64) ((unsigned*)(ws + WS_FLAGS))[gt] = 0u;
    }
    if (nb == 0) grid.sync();
    GRID_SYNC();

    { pg8::Gemm g{XN, W1IN, MP, 2 * DFF, DM}; pg8::StaticOrder S; S.init(MP, 2 * DFF, nb, bid); EpiFfnUp E{HID}; pg8::gemm_phase<EpiFfnUp, pg8::StaticOrder, false>(lds, g, S, E, nullptr); }
    {
        for (int task = gw; task < 32 * 32; task += nw) {
            const int g = task >> 5, j = task & 31, c2 = lane & 15, c1b = lane >> 4;
            const float lpr = LP[((size_t)(g * 33 + j) * 64 + lane) * 2], lpi = LP[((size_t)(g * 33 + j) * 64 + lane) * 2 + 1];
            float a0 = 0.f, a1 = 0.f, a2 = 0.f, a3 = 0.f;
#pragma unroll 4
            for (int pp = 0; pp < 64; ++pp) {
                const float lre = __shfl(lpr, pp), lim = __shfl(lpi, pp);
                const float bre = BB[((size_t)(g * 64 + pp) * 16 + c2) * 2], bim = BB[((size_t)(g * 64 + pp) * 16 + c2) * 2 + 1];
                const float tr = lre * bre - lim * bim, ti = lre * bim + lim * bre;
                const size_t cb = (size_t)(g * 16 + c1b) * 64 + pp;
                a0 += p.in[17][cb] * tr - p.in[18][cb] * ti;
                a1 += p.in[17][cb + 4 * 64] * tr - p.in[18][cb + 4 * 64] * ti;
                a2 += p.in[17][cb + 8 * 64] * tr - p.in[18][cb + 8 * 64] * ti;
                a3 += p.in[17][cb + 12 * 64] * tr - p.in[18][cb + 12 * 64] * ti;
            }
            float* kd = KLAG + (size_t)task * 256 + c2;
            kd[(c1b) * 16] = a0; kd[(c1b + 4) * 16] = a1; kd[(c1b + 8) * 16] = a2; kd[(c1b + 12) * 16] = a3;
        }
        for (int i = gt; i < 32 * 128 * 64; i += nt) {
            const int k8 = (i & 63) * 8, pq = (i >> 6) & 127, g = i >> 13, t1 = k8 >> 4, c20 = k8 & 15, pp = pq & 63;
            const float lre = LP[((size_t)(g * 33 + 31 - t1) * 64 + pp) * 2], lim = LP[((size_t)(g * 33 + 31 - t1) * 64 + pp) * 2 + 1];
            const f32x4* bp = (const f32x4*)(BB + ((size_t)(g * 64 + pp) * 16 + c20) * 2);
            float v[8];
#pragma unroll
            for (int q = 0; q < 4; ++q) { const f32x4 b = bp[q];
                v[2 * q] = (pq < 64) ? (lre * b[0] - lim * b[1]) : (lre * b[1] + lim * b[0]);
                v[2 * q + 1] = (pq < 64) ? (lre * b[2] - lim * b[3]) : (lre * b[3] + lim * b[2]); }
            *(u32x4*)(WEND + (size_t)(g * 128 + pq) * 512 + k8) = pack8(v);
        }
        for (int i = gt; i < 32 * 512 * 16; i += nt) {
            const int pq8 = (i & 15) * 8, n = (i >> 4) & 511, g = i >> 13, t = n >> 4, c1 = n & 15, pp0 = pq8 & 63;
            const f32x4* crp = (const f32x4*)(p.in[17] + (size_t)(g * 16 + c1) * 64 + pp0); const f32x4* cip = (const f32x4*)(p.in[18] + (size_t)(g * 16 + c1) * 64 + pp0);
            const f32x4* lp4 = (const f32x4*)(LP + ((size_t)(g * 33 + t + 1) * 64 + pp0) * 2);
            float v[8];
#pragma unroll
            for (int q = 0; q < 2; ++q) { const f32x4 cr = crp[q], ci = cip[q], l0 = lp4[2 * q], l1 = lp4[2 * q + 1];
                const float lre[4] = {l0[0], l0[2], l1[0], l1[2]}, lim[4] = {l0[1], l0[3], l1[1], l1[3]};
#pragma unroll
                for (int j = 0; j < 4; ++j) v[4 * q + j] = (pq8 < 64) ? (cr[j] * lre[j] - ci[j] * lim[j]) : -(cr[j] * lim[j] + ci[j] * lre[j]); }
            *(u32x4*)(SSMBT + (size_t)(g * 512 + n) * KS + 512 + pq8) = pack8(v);
        }
    }
    GRID_SYNC();

    { pg8::Gemm g{HID, W1OUT, MP, DM, DFF}; pg8::StaticOrder S; S.init(MP, DM, nb, bid); EpiDown E{R, SUMSQ}; pg8::gemm_phase<EpiDown, pg8::StaticOrder, false>(lds, g, S, E, nullptr); }
    small_down<DFF>((LAS float*)lds, HID, W1OUT, R, SUMSQ, bid, nb, tid, wid, lane);
    for (int i = gt; i < 32 * 512 * 64; i += nt) {
        const int k8 = (i & 63) * 8, n = (i >> 6) & 511, g = i >> 15, t = n >> 4, c1 = n & 15, t1 = k8 >> 4, c20 = k8 & 15; float v[8];
#pragma unroll
        for (int j = 0; j < 8; ++j) v[j] = 0.f;
        if (t1 <= t) { const f32x4* kp = (const f32x4*)(KLAG + (size_t)((g * 32 + (t - t1)) * 16 + c1) * 16 + c20); const f32x4 a = kp[0], b = kp[1];
#pragma unroll
            for (int j = 0; j < 4; ++j) { v[j] = a[j]; v[4 + j] = b[j]; } }
        *(u32x4*)(SSMBT + (size_t)(g * 512 + n) * KS + k8) = pack8(v);
    }
    GRID_SYNC();

    {
        constexpr int NS3 = 24;
        if (bid < NS3) {
            row_phase<0, 4>(p, SUMSQ, p.in[8], RSTD + MT, RSTD, MP, MT, bid * 8 + wid, NS3 * 8, lane);
            sub_barrier((unsigned*)(ws + WS_BAR) + 64 * 17, NS3, tid);
            pg8::Gemm g{Hb, WIN, MT, NPROJ, DM}; OneUnit S{256 + bid / 12, bid % 12}; EpiInProj E{Uq, UP, GATES, p.in[11], p.out, RSTD + MT};
            pg8::gemm_phase<EpiInProj, OneUnit, false>(lds, g, S, E, nullptr);
            { LAS float* tile = (LAS float*)lds;
              conv_weight<512, 2048, 1, 1024>(tile, p.in[20], WGLU, nullptr, tid, bid, NS3);
              conv_weight<1024, 1024, 0, 0>(tile, p.in[24], WOUT, nullptr, tid, bid, NS3); }
        } else row_phase<0, 4>(p, SUMSQ, p.in[8], RSTD + MT, RSTD, 0, MP, (bid - NS3) * 8 + wid, (nb - NS3) * 8, lane);
    }
    GRID_SYNC();

    { pg8::Gemm g{Hb, WIN, MP, NPROJ, DM}; pg8::StaticOrder S; S.init(MP, NPROJ, nb, bid); EpiInProj E{Uq, UP, GATES, p.in[11], p.out, RSTD + MT}; pg8::gemm_phase<EpiInProj, pg8::StaticOrder, false>(lds, g, S, E, nullptr); }
    GRID_SYNC();

    {
        for (int task = gw; task < 32 * 64; task += nw) {
            const int g = task >> 6, cr0 = (task & 63) * 32;
            f32x16 acc[4];
#pragma unroll
            for (int q = 0; q < 4; ++q)
#pragma unroll
                for (int j = 0; j < 16; ++j) acc[q][j] = 0.f;
            const bf16_t* Ab = Uq + ((size_t)(g * CRP + cr0 + (lane & 31)) * KS + 8 * (lane >> 5));
            const bf16_t* Bb = WEND + ((size_t)(g * 128 + (lane & 31)) * 512 + 8 * (lane >> 5));
#pragma unroll 4
            for (int k0 = 0; k0 < 512; k0 += 16) {
                const bf16x8 a = *(const bf16x8*)(Ab + k0);
#pragma unroll
                for (int q = 0; q < 4; ++q) { const bf16x8 b = *(const bf16x8*)(Bb + (size_t)q * 32 * 512 + k0); acc[q] = __builtin_amdgcn_mfma_f32_32x32x16_bf16(a, b, acc[q], 0, 0, 0); }
            }
#pragma unroll
            for (int q = 0; q < 4; ++q)
#pragma unroll
                for (int j = 0; j < 16; ++j) { const int row = (j & 3) + 8 * (j >> 2) + 4 * (lane >> 5); Eb[(size_t)(g * CRP + cr0 + row) * 128 + q * 32 + (lane & 31)] = acc[q][j]; }
        }
        for (int i = gt; i < 2048 * 64; i += nt) POOLED_TASK(i);
        for (int i = gt; i < 16 * 64 * 4; i += nt) pooled_task((2048 + (i >> 8)) * 64 + ((i >> 2) & 63), 8 * (i & 3), 8, UP, POOLED, p);
    }
    GRID_SYNC();

    {
        for (int task = gw; task < 8 * 32 + 16 * 32; task += nw) {
            const bool smp = task >= 256; const int tk = smp ? task - 256 : task, b = tk >> 5, g = tk & 31;
            const float l32r = LP[((size_t)(g * 33 + 32) * 64 + lane) * 2], l32i = LP[((size_t)(g * 33 + 32) * 64 + lane) * 2 + 1];
            float sr = 0.f, si = 0.f; int cr = b * 256, nk = 256;
            if (smp) { sr = p.in[2][(size_t)(b * 32 + g) * 64 + lane]; si = p.in[3][(size_t)(b * 32 + g) * 64 + lane]; cr = 2048 + b; nk = 1; }
            if (smp) {
                const size_t base = (size_t)(g * CRP + cr);
                Uq[base * KS + 512 + lane] = (bf16_t)(cvt_pk_bf16(sr, 0.f) & 0xffffu);
                Uq[base * KS + 576 + lane] = (bf16_t)(cvt_pk_bf16(si, 0.f) & 0xffffu);
                float er = 0.f, ei = 0.f;
                { const bf16_t* ur = Uq + base * KS; const bf16_t* wre = WEND + (size_t)(g * 128 + lane) * 512; const bf16_t* wim = wre + (size_t)64 * 512;
                  for (int k = 0; k < 512; k += 8) { float uu[8], a8[8], b8[8]; unpack8(*(const u32x4*)(ur + k), uu); unpack8(*(const u32x4*)(wre + k), a8); unpack8(*(const u32x4*)(wim + k), b8);
                      for (int j = 0; j < 8; ++j) { er += uu[j] * a8[j]; ei += uu[j] * b8[j]; } } }
                const float nr = l32r * sr - l32i * si + er, ni = l32r * si + l32i * sr + ei;
                sr = nr; si = ni;
            } else {
                for (int k0 = 0; k0 < 256; k0 += 16) {
                    float er[16], ei[16];
#pragma unroll
                    for (int q = 0; q < 16; ++q) { const size_t base = (size_t)(g * CRP + cr + k0 + q); er[q] = Eb[base * 128 + lane]; ei[q] = Eb[base * 128 + 64 + lane]; }
#pragma unroll
                    for (int q = 0; q < 16; ++q) {
                        const size_t base = (size_t)(g * CRP + cr + k0 + q);
                        Uq[base * KS + 512 + lane] = (bf16_t)(cvt_pk_bf16(sr, 0.f) & 0xffffu);
                        Uq[base * KS + 576 + lane] = (bf16_t)(cvt_pk_bf16(si, 0.f) & 0xffffu);
                        const float nr = l32r * sr - l32i * si + er[q], ni = l32r * si + l32i * sr + ei[q];
                        sr = nr; si = ni;
                    }
                }
            }
            const size_t o = (size_t)(b * 32 + g) * 64 + lane;
            if (smp) { p.out[OUT_RE_S + o] = sr; p.out[OUT_IM_S + o] = si; } else { p.out[OUT_RE_P + o] = sr; p.out[OUT_IM_P + o] = si; }
        }
    }
    {
        const int sb = (nb > 64) ? 32 : 0;
        if (bid >= sb) {
        { int kpool = 256; asm volatile("" : "+s"(kpool));
          pg8::Gemm g{POOLED, WPOOL, 2 * MT, DM, kpool}; PoolOrder S{nb - sb, bid - sb}; EpiPool E{GATES, PMb}; pg8::gemm_phase<EpiPool, PoolOrder, false>(lds, g, S, E, nullptr); }
        }
    }
    GRID_SYNC();

    { pg8::Gemm g{Uq, SSMBT, 32 * CRP, 32 * 512, KS}; GroupOrder S{nb, bid}; EpiSsm E{Uq, YG, p.in[19]}; pg8::gemm_phase<EpiSsm, GroupOrder, false>(lds, g, S, E, nullptr); }
    small_ssm(Uq, SSMBT, YG, p.in[19], gw, nw, lane);
    GRID_SYNC();

    { pg8::Gemm g{YG, WGLU, MT, 2 * DM, 512}; pg8::StaticOrder S; S.init(MT, 2 * DM, nb, bid); EpiGlu E{GATES, PMb, MERGED, p.in[21]}; pg8::gemm_phase<EpiGlu, pg8::StaticOrder, false>(lds, g, S, E, nullptr); }
    { const int t6 = (258 * 8) % nb;
      if (bid >= t6) { LAS float* tile = (LAS float*)lds;
        conv_weight<1024, 5632, 1, 2816>(tile, p.in[27], W2IN, p.in[26], tid, bid - t6, nb - t6);
        conv_weight<2816, 1024, 0, 0>(tile, p.in[28], W2OUT, nullptr, tid, bid - t6, nb - t6); } }
    GRID_SYNC();

    { pg8::Gemm g{MERGED, WOUT, MP, DM, DM}; pg8::StaticOrder S; S.init(MP, DM, nb, bid); EpiDown E{R, SUMSQ + MT}; pg8::gemm_phase<EpiDown, pg8::StaticOrder, false>(lds, g, S, E, nullptr); }
    small_down<DM>((LAS float*)lds, MERGED, WOUT, R, SUMSQ + MT, bid, nb, tid, wid, lane);
    GRID_SYNC();

    {
        constexpr int NS8 = 44;
        if (bid < NS8) {
            row_phase<1, 4>(p, SUMSQ + MT, p.in[25], RSTD + 2 * MT, nullptr, MP, MT, bid * 8 + wid, NS8 * 8, lane);
            sub_barrier((unsigned*)(ws + WS_BAR) + 64 * 18, NS8, tid);
            pg8::Gemm g{XN, W2IN, MT, 2 * DFF, DM}; OneUnit S{256 + bid / 22, bid % 22}; EpiFfnUp E{HID};
            pg8::gemm_phase<EpiFfnUp, OneUnit, false>(lds, g, S, E, nullptr);
        } else row_phase<1, 4>(p, SUMSQ + MT, p.in[25], RSTD + 2 * MT, nullptr, 0, MP, (bid - NS8) * 8 + wid, (nb - NS8) * 8, lane);
    }
    GRID_SYNC();

    { pg8::Gemm g{XN, W2IN, MP, 2 * DFF, DM}; pg8::StaticOrder S; S.init(MP, 2 * DFF, nb, bid); EpiFfnUp E{HID}; pg8::gemm_phase<EpiFfnUp, pg8::StaticOrder, false>(lds, g, S, E, nullptr); }
    GRID_SYNC();

    { pg8::Gemm g{HID, W2OUT, MP, DM, DFF}; pg8::StaticOrder S; S.init(MP, DM, nb, bid); EpiDown E{R, SUMSQ + 2 * MT}; pg8::gemm_phase<EpiDown, pg8::StaticOrder, false>(lds, g, S, E, nullptr); }
    small_down<DFF>((LAS float*)lds, HID, W2OUT, R, SUMSQ + 2 * MT, bid, nb, tid, wid, lane);
    GRID_SYNC();

    row_phase<2, 4>(p, SUMSQ + 2 * MT, p.in[29], nullptr, RSTD + 2 * MT, 0, MT, gw, nw, lane);
}

extern "C" void kernel_launch(void* const* d_in, const int* in_sizes, int n_in, void* d_out, int out_size, void* d_ws, size_t ws_size, hipStream_t stream) {
    constexpr int LDS_BYTES = pg8::STAGE_BYTES;
    static int grid = 0;
    if (grid == 0) {
        if (n_in != 30 || ws_size < WS_END) { fprintf(stderr, "kernel_launch: expected 30 inputs and >= %zu bytes of workspace; got %d, %zu\n", (size_t)WS_END, n_in, ws_size); grid = -1; return; }
        int dev = 0, cus = 0, per_cu = 0;
        hipGetDevice(&dev); hipDeviceGetAttribute(&cus, hipDeviceAttributeMultiprocessorCount, dev);
        if (hipFuncSetAttribute((const void*)fwd_megakernel, hipFuncAttributeMaxDynamicSharedMemorySize, LDS_BYTES) != hipSuccess) { fprintf(stderr, "kernel_launch: hipFuncSetAttribute failed\n"); grid = -1; return; }
        if (hipOccupancyMaxActiveBlocksPerMultiprocessor(&per_cu, (const void*)fwd_megakernel, 512, LDS_BYTES) != hipSuccess || per_cu < 1) { fprintf(stderr, "kernel_launch: occupancy query says %d blocks per CU\n", per_cu); (void)hipGetLastError(); per_cu = 1; }
        grid = cus;
    }
    if (grid < 0) return;
    Params p{};
    for (int i = 0; i < 30; ++i) p.in[i] = (const float*)d_in[i];
    p.out = (float*)d_out; p.ws = (unsigned char*)d_ws;
    if (hipMemsetAsync((unsigned char*)d_ws + WS_BAR, 0, WS_BAR_BYTES, stream) != hipSuccess) { fprintf(stderr, "kernel_launch: hipMemsetAsync failed\n"); return; }
    void* args[] = {&p};
    hipError_t e = hipLaunchCooperativeKernel((const void*)fwd_megakernel, dim3(grid), dim3(512), args, LDS_BYTES, stream);
    if (e != hipSuccess) fprintf(stderr, "kernel_launch: cooperative launch failed: %s (grid %d)\n", hipGetErrorString(e), grid);
}
```

```cpp
#include <hip/hip_runtime.h>
#include <hip/hip_cooperative_groups.h>
#include <cstdio>
namespace pg8 {
#define PG8_LAS __attribute__((address_space(3)))
typedef unsigned short bf16_t;
typedef short bf16x8 __attribute__((ext_vector_type(8)));
typedef float f32x4 __attribute__((ext_vector_type(4)));
typedef unsigned u32x4 __attribute__((ext_vector_type(4)));
constexpr int BM = 256, BK = 64, HALF = 128, HTB = HALF * BK * 2  , STAGE_BYTES = 8 * HTB, NXCD = 8, WGM = 8;

__host__ __device__ __forceinline__ int lds_byte(int r, int c) { const int st = (r >> 4) * 2 + (c >> 5), rr = r & 15, cc = c & 31, ob = rr * 64 + cc * 2; return st * 1024 + (ob ^ (((ob >> 9) & 1) << 5)); }
__host__ __device__ __forceinline__ void stage_rc(int b, int& R, int& C) { const int st = b / 1024, sb = b % 1024, swz = sb ^ (((sb >> 9) & 1) << 5); R = (st >> 1) * 16 + swz / 64; C = (st & 1) * 32 + (swz % 64) / 2; }
__host__ __device__ __forceinline__ int perm32(int rho) { const int n = rho >> 4, i = rho & 15; return 8 * (i >> 2) + 4 * n + (i & 3); }

struct Unit { int pm, pn; };
struct Gemm { const bf16_t* A; const bf16_t* Bt; int M, N, K; };

struct StaticOrder {
    int nM, nN, nwg, G, c;
    __host__ __device__ void init(int M, int N, int G_, int c_) { nM = M / BM; nN = N / BM; nwg = nM * nN; G = G_; c = c_; }
    __host__ __device__ bool next(int i, Unit& u) const {
        const long L = (long)i * G + c; if (L >= nwg) return false;
        int wgid = (int)L; { const int q = nwg / NXCD, r = nwg % NXCD, xcd = wgid % NXCD, off = wgid / NXCD; wgid = (xcd < r ? xcd * (q + 1) : r * (q + 1) + (xcd - r) * q) + off; }
        const int nig = WGM * nN, gid = wgid / nig, fm = gid * WGM, gsz = (nM - fm) < WGM ? (nM - fm) : WGM;
        u.pm = fm + ((wgid % nig) % gsz); u.pn = (wgid % nig) / gsz; return true;
    }
    __device__ __forceinline__ void a_ready(const Unit&) const {}
    __device__ __forceinline__ void done(const Unit&) const {}
};
typedef float f32x2c __attribute__((ext_vector_type(2))); typedef __bf16 bf16x2c __attribute__((ext_vector_type(2)));
__device__ __forceinline__ unsigned cvt_pk_bf16(float lo, float hi) { const f32x2c f = {lo, hi}; const bf16x2c b = __builtin_convertvector(f, bf16x2c); return __builtin_bit_cast(unsigned, b); }
typedef float f32x2 __attribute__((ext_vector_type(2)));
template <class Epi, class Sched, bool STAMP = false>
__device__ __forceinline__ void gemm_phase(PG8_LAS unsigned char* lds, const Gemm g, const Sched& S, const Epi& E, unsigned long long* stamps) {
    int tid_; asm volatile("v_mov_b32 %0, %1" : "=v"(tid_) : "v"((int)threadIdx.x)); const int tid = tid_, wid = __builtin_amdgcn_readfirstlane(tid >> 6), lane = tid & 63, wr = wid >> 2, wc = wid & 3, fr = lane & 15, fq = lane >> 4;
    const int K = g.K, nt = K / BK;
    int ts_lo = 0, ts_hi = 0, nts = 0; const unsigned long long rt_entry = STAMP ? (unsigned long long)wall_clock64() : 0ull;
#define PG8_STAMP() do { if (STAMP && wid == 0 && nts < 64) { const unsigned long long _c = (unsigned long long)clock64(); \
        ts_lo = (lane == nts) ? (int)(unsigned)_c : ts_lo; ts_hi = (lane == nts) ? (int)(unsigned)(_c >> 32) : ts_hi; ++nts; } } while (0)
    PG8_STAMP();
    unsigned voffA[2], voffB[2];
#pragma unroll
    for (int i = 0; i < 2; ++i) { int R, C; stage_rc(tid * 16 + i * 8192, R, C); const int Rb = Epi::PERM ? ((R & ~31) + perm32(R & 31)) : R;
        voffA[i] = (unsigned)(R * K + C) * 2u; voffB[i] = (unsigned)(Rb * K + C) * 2u; }
    const size_t kstep = (size_t)(BK * 2);
    const size_t hstep = (size_t)HALF * K * 2;
    const size_t tstep = 2 * hstep;
    const unsigned ldsw = (unsigned)wid * 1024u;
    const int aoff = lds_byte(wr * 64 + fr, fq * 8), boff = lds_byte(wc * 32 + fr, fq * 8);
#define PG8_SA(b, h) (((b) * 2 + (h)) * HTB)
#define PG8_SB(b, h) ((4 + (b) * 2 + (h)) * HTB)
#define PG8_STAGE(bufoff, gbase, voff) do { _Pragma("unroll") for (int _i = 0; _i < 2; ++_i) \
        __builtin_amdgcn_global_load_lds((const unsigned*)((const char*)(gbase) + (voff)[_i]), (PG8_LAS unsigned*)(lds + (bufoff) + ldsw + _i * 8192), 16, 0, 0); } while (0)
#define PG8_LDA(dst, b, h) do { _Pragma("unroll") for (int m = 0; m < 4; ++m) _Pragma("unroll") for (int k = 0; k < 2; ++k) dst[m][k] = *(const PG8_LAS bf16x8*)(lds + PG8_SA(b, h) + aoff + m * 2048 + k * 1024); } while (0)
#define PG8_LDB(dst, b, h) do { _Pragma("unroll") for (int n = 0; n < 2; ++n) _Pragma("unroll") for (int k = 0; k < 2; ++k) dst[n][k] = *(const PG8_LAS bf16x8*)(lds + PG8_SB(b, h) + boff + n * 2048 + k * 1024); } while (0)
#define PG8_MMA(ai, bj, At, Bt) do { __builtin_amdgcn_s_setprio(1); _Pragma("unroll") for (int m = 0; m < 4; ++m) _Pragma("unroll") for (int n = 0; n < 2; ++n) _Pragma("unroll") for (int k = 0; k < 2; ++k) \
        acc[ai][bj][m][n] = __builtin_amdgcn_mfma_f32_16x16x32_bf16(Bt[n][k], At[m][k], acc[ai][bj][m][n], 0, 0, 0); __builtin_amdgcn_s_setprio(0); } while (0)
#define PG8_WAIT_V(n) asm volatile("s_waitcnt vmcnt(" #n ")" ::: "memory")
#define PG8_WAIT_L(n) asm volatile("s_waitcnt lgkmcnt(" #n ")" ::: "memory")
#define PG8_BAR __builtin_amdgcn_s_barrier()
#define PG8_SCHED __builtin_amdgcn_sched_barrier(0)
    Unit cur, nxt; int ui = 0;
    if (!S.next(0, cur)) return;
    f32x4 acc[2][2][4][2];
#pragma unroll
    for (int a = 0; a < 2; ++a)
#pragma unroll
        for (int b = 0; b < 2; ++b)
#pragma unroll
            for (int m = 0; m < 4; ++m)
#pragma unroll
                for (int n = 0; n < 2; ++n) acc[a][b][m][n] = (f32x4){0.f, 0.f, 0.f, 0.f};
    bf16x8 At[4][2], B0[2][2], B1[2][2];
    const char* cA = (const char*)g.A + (size_t)cur.pm * tstep; const char* cB = (const char*)g.Bt + (size_t)cur.pn * tstep;
    S.a_ready(cur);
    PG8_STAGE(PG8_SB(0, 0), cB, voffB); PG8_STAGE(PG8_SA(0, 0), cA, voffA); PG8_STAGE(PG8_SB(0, 1), cB + hstep, voffB); PG8_STAGE(PG8_SA(0, 1), cA + hstep, voffA);
    if (wr == 1) PG8_BAR;
    PG8_WAIT_V(4); PG8_BAR;
    PG8_STAGE(PG8_SB(1, 0), cB + kstep, voffB); PG8_STAGE(PG8_SA(1, 0), cA + kstep, voffA); PG8_STAGE(PG8_SB(1, 1), cB + hstep + kstep, voffB);
    PG8_WAIT_V(6); PG8_BAR;
    PG8_STAMP();
    for (;;) {
        const bool has_next = S.next(ui + 1, nxt);
        const char* nA = has_next ? (const char*)g.A + (size_t)nxt.pm * tstep : cA; const char* nB = has_next ? (const char*)g.Bt + (size_t)nxt.pn * tstep : cB;
        for (int t = 0; t < nt; t += 2) {
            const bool last = (t == nt - 2);
            const char* a1 = cA + (size_t)(t + 1) * kstep;
            const char* a2 = last ? nA : cA + (size_t)(t + 2) * kstep; const char* b2 = last ? nB : cB + (size_t)(t + 2) * kstep;
            const char* a3 = a2 + kstep; const char* b3 = b2 + kstep;
            if (last && has_next) S.a_ready(nxt);
            PG8_LDB(B0, 0, 0); PG8_SCHED; PG8_LDA(At, 0, 0); PG8_STAGE(PG8_SA(1, 1), a1 + hstep, voffA);
            PG8_WAIT_L(8); PG8_BAR; PG8_WAIT_L(0); PG8_MMA(0, 0, At, B0); PG8_BAR; PG8_SCHED;
            PG8_LDB(B1, 0, 1); PG8_STAGE(PG8_SB(0, 0), b2, voffB);
            PG8_BAR; PG8_WAIT_L(0); PG8_MMA(0, 1, At, B1); PG8_BAR;
            PG8_LDA(At, 0, 1); PG8_STAGE(PG8_SA(0, 0), a2, voffA);
            PG8_BAR; PG8_WAIT_L(0); PG8_MMA(1, 0, At, B0); PG8_BAR; PG8_SCHED;
            PG8_STAGE(PG8_SB(0, 1), b2 + hstep, voffB);
            PG8_WAIT_V(6); PG8_BAR; PG8_MMA(1, 1, At, B1); PG8_BAR;
            PG8_LDB(B0, 1, 0); PG8_SCHED; PG8_LDA(At, 1, 0); PG8_STAGE(PG8_SA(0, 1), a2 + hstep, voffA);
            PG8_WAIT_L(8); PG8_BAR; PG8_WAIT_L(0); PG8_MMA(0, 0, At, B0); PG8_BAR; PG8_SCHED;
            PG8_LDB(B1, 1, 1); PG8_STAGE(PG8_SB(1, 0), b3, voffB);
            PG8_BAR; PG8_WAIT_L(0); PG8_MMA(0, 1, At, B1); PG8_BAR;
            PG8_LDA(At, 1, 1); PG8_STAGE(PG8_SA(1, 0), a3, voffA);
            PG8_BAR; PG8_WAIT_L(0); PG8_MMA(1, 0, At, B0); PG8_BAR; PG8_SCHED;
            PG8_STAGE(PG8_SB(1, 1), b3 + hstep, voffB);
            PG8_WAIT_V(6); PG8_BAR; PG8_MMA(1, 1, At, B1); PG8_BAR;
        }
        PG8_STAMP();
        if constexpr (!Epi::AFTER_DRAIN) { E(acc, cur, wr, wc, fr, fq); S.done(cur); }
        PG8_STAMP();
        if (!has_next) break;
#pragma unroll
        for (int a = 0; a < 2; ++a)
#pragma unroll
            for (int b = 0; b < 2; ++b)
#pragma unroll
                for (int m = 0; m < 4; ++m)
#pragma unroll
                    for (int n = 0; n < 2; ++n) acc[a][b][m][n] = (f32x4){0.f, 0.f, 0.f, 0.f};
        cur = nxt; cA = nA; cB = nB; ++ui;
    }
    PG8_WAIT_V(0);
    if (wr == 0) PG8_BAR;
    PG8_BAR;
    if constexpr (Epi::AFTER_DRAIN) { E.fused(acc, cur, wr, wc, fr, fq, lds, wid, lane); S.done(cur); }
    PG8_STAMP();
    if (STAMP && wid == 0) { stamps[lane] = lane < nts ? (((unsigned long long)(unsigned)ts_hi << 32) | (unsigned)ts_lo) : 0ull;
        if (lane == 62) stamps[62] = rt_entry; if (lane == 63) stamps[63] = (unsigned long long)wall_clock64(); }
#undef PG8_STAMP
#undef PG8_SA
#undef PG8_SB
#undef PG8_STAGE
#undef PG8_LDA
#undef PG8_LDB
#undef PG8_MMA
#undef PG8_WAIT_V
#undef PG8_WAIT_L
#undef PG8_BAR
#undef PG8_SCHED
}
}

namespace cg = cooperative_groups;
using pg8::bf16_t; using pg8::bf16x8; using pg8::f32x4; using pg8::u32x4; using pg8::Unit; using pg8::cvt_pk_bf16;
typedef float f32x16 __attribute__((ext_vector_type(16)));
#define LAS PG8_LAS

constexpr int MP = 65536, MS = 512, MT = MP + MS;
constexpr int DM = 1024, DFF = 2816, NPROJ = 3072;
constexpr int NCR = 2064, CRP = 2304, KS = 640;
constexpr float EPS = 1e-6f;

constexpr size_t SZ_ACT = (size_t)MT * DM * 2;
constexpr size_t WS_XN = 0;
constexpr size_t WS_HID = WS_XN + SZ_ACT;
constexpr size_t SZ_HID = (size_t)MT * DFF * 2;
constexpr size_t WS_R = WS_HID + SZ_HID;
constexpr size_t WS_H = WS_R + SZ_ACT;
constexpr size_t WS_W1IN = WS_H + SZ_ACT;
constexpr size_t WS_W1OUT = WS_W1IN + (size_t)5632 * 1024 * 2;
constexpr size_t WS_WIN = WS_W1OUT + (size_t)1024 * 2816 * 2;
constexpr size_t WS_WGLU = WS_WIN + (size_t)3072 * 1024 * 2;
constexpr size_t WS_WPOOL = WS_WGLU + (size_t)2048 * 512 * 2;
constexpr size_t WS_WOUT = WS_WPOOL + (size_t)1024 * 512 * 2;
constexpr size_t WS_W2IN = WS_WOUT + (size_t)1024 * 1024 * 2;
constexpr size_t WS_W2OUT = WS_W2IN + (size_t)5632 * 1024 * 2;
constexpr size_t WS_SSMBT = WS_W2OUT + (size_t)1024 * 2816 * 2;
constexpr size_t WS_WEND = WS_SSMBT + (size_t)32 * 512 * KS * 2;
constexpr size_t WS_KLAG = WS_WEND + (size_t)32 * 128 * 512 * 2;
constexpr size_t WS_LP = WS_KLAG + (size_t)32 * 32 * 256 * 4;
constexpr size_t WS_BB = WS_LP + (size_t)32 * 33 * 64 * 8;
constexpr size_t WS_SUMSQ = WS_BB + (size_t)32 * 64 * 16 * 8;
constexpr size_t WS_FLAGS = WS_SUMSQ + (size_t)3 * MT * 4;
constexpr size_t WS_BAR = WS_FLAGS + 256;
constexpr size_t WS_BAR_BYTES = 24 * 256;
constexpr size_t WS_RSTD = WS_BAR + WS_BAR_BYTES;
constexpr size_t WS_UPD = (WS_RSTD + (size_t)3 * MT * 4 + 255) & ~(size_t)255;
constexpr size_t WS_END = WS_UPD + (size_t)MT * 512 * 2;
constexpr size_t WS_GATES = WS_HID;
constexpr size_t WS_POOLED = WS_HID + (size_t)MT * 2048 * 2;
constexpr size_t WS_UP = WS_UPD;
constexpr size_t WS_PM = WS_R;
constexpr size_t WS_E = WS_XN;
constexpr size_t WS_MERGED = WS_XN;
static_assert(WS_POOLED + (size_t)MT * 512 * 2 <= WS_R, "hid region overflow");
constexpr size_t DO_U = 0;
constexpr size_t DO_YG = (size_t)32 * CRP * KS * 2;
static_assert(DO_YG + (size_t)MT * 512 * 2 <= (size_t)MT * DM * 4, "d_out scratch overflow");
constexpr size_t OUT_Y = 0;
constexpr size_t OUT_RE_P = (size_t)MT * DM;
constexpr size_t OUT_IM_P = OUT_RE_P + 16384;
constexpr size_t OUT_POOL_P = OUT_IM_P + 16384;
constexpr size_t OUT_RE_S = OUT_POOL_P + 61440;
constexpr size_t OUT_IM_S = OUT_RE_S + 32768;
constexpr size_t OUT_POOL_S = OUT_IM_S + 32768;

struct Params { const float* in[30]; float* out; unsigned char* ws; };

__device__ __forceinline__ float bflo(unsigned w) { return __uint_as_float(w << 16); }
__device__ __forceinline__ float bfhi(unsigned w) { return __uint_as_float(w & 0xffff0000u); }
__device__ __forceinline__ float fast_sigmoid(float x) { return __builtin_amdgcn_rcpf(1.0f + __expf(-x)); }
__device__ __forceinline__ float wave_sum(float s) {
#pragma unroll
    for (int o = 32; o >= 1; o >>= 1) s += __shfl_xor(s, o);
    return s;
}
__device__ __forceinline__ void unpack8(const u32x4 w, float (&v)[8]) {
    v[0] = bflo(w.x); v[1] = bfhi(w.x); v[2] = bflo(w.y); v[3] = bfhi(w.y); v[4] = bflo(w.z); v[5] = bfhi(w.z); v[6] = bflo(w.w); v[7] = bfhi(w.w);
}
__device__ __forceinline__ u32x4 pack8(const float (&v)[8]) {
    u32x4 w; w.x = cvt_pk_bf16(v[0], v[1]); w.y = cvt_pk_bf16(v[2], v[3]); w.z = cvt_pk_bf16(v[4], v[5]); w.w = cvt_pk_bf16(v[6], v[7]); return w;
}

struct EpiFfnUp {
    static constexpr bool PERM = true, AFTER_DRAIN = false;
    bf16_t* O;
    __device__ __forceinline__ void operator()(const f32x4 (&acc)[2][2][4][2], const Unit& u, int wr, int wc, int fr, int fq) const {
        const int row0 = u.pm * 256 + wr * 64 + fr, col0 = u.pn * 128 + wc * 32 + 8 * fq;
#pragma unroll
        for (int ai = 0; ai < 2; ++ai)
#pragma unroll
            for (int m = 0; m < 4; ++m) {
                float v[8];
#pragma unroll
                for (int n = 0; n < 2; ++n)
#pragma unroll
                    for (int j = 0; j < 4; ++j) { const float a = acc[ai][0][m][n][j], b = acc[ai][1][m][n][j]; v[n * 4 + j] = a * fast_sigmoid(a) * b; }
                *(u32x4*)(O + (size_t)(row0 + ai * 128 + m * 16) * DFF + col0) = pack8(v);
            }
    }
};
struct EpiDown {
    static constexpr bool PERM = true, AFTER_DRAIN = false;
    bf16_t* O; float* sumsq;
    __device__ __forceinline__ void operator()(const f32x4 (&acc)[2][2][4][2], const Unit& u, int wr, int wc, int fr, int fq) const {
        const int row0 = u.pm * 256 + wr * 64 + fr, col0 = u.pn * 256 + wc * 32 + 8 * fq;
#pragma unroll
        for (int ai = 0; ai < 2; ++ai)
#pragma unroll
            for (int m = 0; m < 4; ++m) {
                const int row = row0 + ai * 128 + m * 16; float s = 0.f;
#pragma unroll
                for (int bj = 0; bj < 2; ++bj) {
                    float v[8];
#pragma unroll
                    for (int n = 0; n < 2; ++n)
#pragma unroll
                        for (int j = 0; j < 4; ++j) { const float a = acc[ai][bj][m][n][j]; v[n * 4 + j] = a; s += a * a; }
                    *(u32x4*)(O + (size_t)row * DM + col0 + bj * 128) = pack8(v);
                }
                s += __shfl_xor(s, 16); s += __shfl_xor(s, 32);
                if (fq == 0) atomicAdd(sumsq + row, s);
            }
    }
};
struct EpiInProj {
    static constexpr bool PERM = true, AFTER_DRAIN = false;
    bf16_t* U; bf16_t* UP; bf16_t* GT; const float* bias; float* out; const float* rs;
    __device__ __forceinline__ void operator()(const f32x4 (&acc)[2][2][4][2], const Unit& u, int wr, int wc, int fr, int fq) const {
        const int row0 = u.pm * 256 + wr * 64 + fr;
#pragma unroll
        for (int bj = 0; bj < 2; ++bj) {
            const int col = u.pn * 256 + bj * 128 + wc * 32 + 8 * fq;
            const f32x4 b0 = *(const f32x4*)(bias + col), b1 = *(const f32x4*)(bias + col + 4);
#pragma unroll
            for (int ai = 0; ai < 2; ++ai)
#pragma unroll
                for (int m = 0; m < 4; ++m) {
                    const int row = row0 + ai * 128 + m * 16; const float r = rs[row];
                    float v[8];
#pragma unroll
                    for (int j = 0; j < 4; ++j) { v[j] = acc[ai][bj][m][0][j] * r + b0[j]; v[4 + j] = acc[ai][bj][m][1][j] * r + b1[j]; }
                    if (u.pn < 2) {
                        const int g = col >> 4, cc = col & 15, cr = row >> 5, t = row & 31;
                        *(u32x4*)(U + ((size_t)(g * CRP + cr) * KS + t * 16 + cc)) = pack8(v);
                    } else if (u.pn < 4) {
                        const int c = col - 512;
                        *(u32x4*)(UP + (size_t)row * 512 + c) = pack8(v);
                        int hr = -1; size_t ob = 0;
                        if (row < MP) { const int tt = row & 8191; if (tt >= 8177) { hr = tt - 8177; ob = OUT_POOL_P + (size_t)((row >> 13) * 15 + hr) * 512; } }
                        else { const int tt = row & 31; if (tt >= 17) { hr = tt - 17; ob = OUT_POOL_S + (size_t)(((row - MP) >> 5) * 15 + hr) * 512; } }
                        if (hr >= 0) { *(f32x4*)(out + ob + c) = (f32x4){v[0], v[1], v[2], v[3]}; *(f32x4*)(out + ob + c + 4) = (f32x4){v[4], v[5], v[6], v[7]}; }
                    } else {
#pragma unroll
                        for (int j = 0; j < 8; ++j) v[j] = fast_sigmoid(v[j]);
                        *(u32x4*)(GT + (size_t)row * 2048 + (col - 1024)) = pack8(v);
                    }
                }
        }
    }
};
struct EpiSsm {
    static constexpr bool PERM = true, AFTER_DRAIN = false;
    const bf16_t* U; bf16_t* YG; const float* dskip;
    __device__ __forceinline__ void operator()(const f32x4 (&acc)[2][2][4][2], const Unit& u, int wr, int wc, int fr, int fq) const {
        const int g = u.pn >> 1, cr0 = (u.pm - 9 * g) * 256 + wr * 64 + fr;
#pragma unroll
        for (int bj = 0; bj < 2; ++bj) {
            const int col = (u.pn & 1) * 256 + bj * 128 + wc * 32 + 8 * fq, t = col >> 4, cc = col & 15, ch = g * 16 + cc;
            const f32x4 d0 = *(const f32x4*)(dskip + ch), d1 = *(const f32x4*)(dskip + ch + 4);
#pragma unroll
            for (int ai = 0; ai < 2; ++ai)
#pragma unroll
                for (int m = 0; m < 4; ++m) {
                    const int cr = cr0 + ai * 128 + m * 16;
                    if (cr < NCR) {
                        const u32x4 uw = *(const u32x4*)(U + ((size_t)(g * CRP + cr) * KS + col));
                        float uu[8], v[8]; unpack8(uw, uu);
#pragma unroll
                        for (int j = 0; j < 4; ++j) { v[j] = acc[ai][bj][m][0][j] + d0[j] * uu[j]; v[4 + j] = acc[ai][bj][m][1][j] + d1[j] * uu[4 + j]; }
#pragma unroll
                        for (int j = 0; j < 8; ++j) { const float x = v[j]; v[j] = x * fast_sigmoid(1.5957691216f * (x + 0.044715f * x * x * x)); }
                        *(u32x4*)(YG + (size_t)(cr * 32 + t) * 512 + ch) = pack8(v);
                    }
                }
        }
    }
};
struct EpiPool {
    static constexpr bool PERM = true, AFTER_DRAIN = false;
    const bf16_t* GT; bf16_t* PM;
    __device__ __forceinline__ void operator()(const f32x4 (&acc)[2][2][4][2], const Unit& u, int wr, int wc, int fr, int fq) const {
        const int row0 = (u.pm % 258) * 256 + wr * 64 + fr, col0 = u.pn * 256 + wc * 32 + 8 * fq;
#pragma unroll
        for (int ai = 0; ai < 2; ++ai)
#pragma unroll
            for (int m = 0; m < 4; ++m) {
                const int row = row0 + ai * 128 + m * 16;
#pragma unroll
                for (int bj = 0; bj < 2; ++bj) {
                    const int col = col0 + bj * 128;
                    const u32x4 gw = *(const u32x4*)(GT + (size_t)row * 2048 + 1024 + col);
                    float gg[8], v[8]; unpack8(gw, gg);
#pragma unroll
                    for (int j = 0; j < 4; ++j) { v[j] = acc[ai][bj][m][0][j] * gg[j]; v[4 + j] = acc[ai][bj][m][1][j] * gg[4 + j]; }
                    *(u32x4*)(PM + (size_t)row * DM + col) = pack8(v);
                }
            }
    }
};
struct EpiGlu {
    static constexpr bool PERM = true, AFTER_DRAIN = false;
    const bf16_t* GT; const bf16_t* PM; bf16_t* MG; const float* bias;
    __device__ __forceinline__ void operator()(const f32x4 (&acc)[2][2][4][2], const Unit& u, int wr, int wc, int fr, int fq) const {
        const int row0 = u.pm * 256 + wr * 64 + fr, col = u.pn * 128 + wc * 32 + 8 * fq;
        const f32x4 ba0 = *(const f32x4*)(bias + col), ba1 = *(const f32x4*)(bias + col + 4), bg0 = *(const f32x4*)(bias + 1024 + col), bg1 = *(const f32x4*)(bias + 1024 + col + 4);
#pragma unroll
        for (int ai = 0; ai < 2; ++ai)
#pragma unroll
            for (int m = 0; m < 4; ++m) {
                const int row = row0 + ai * 128 + m * 16;
                const u32x4 gw = *(const u32x4*)(GT + (size_t)row * 2048 + col), pw = *(const u32x4*)(PM + (size_t)row * DM + col);
                float gs[8], pm[8], v[8]; unpack8(gw, gs); unpack8(pw, pm);
#pragma unroll
                for (int j = 0; j < 4; ++j) {
                    v[j] = gs[j] * ((acc[ai][0][m][0][j] + ba0[j]) * fast_sigmoid(acc[ai][1][m][0][j] + bg0[j])) + pm[j];
                    v[4 + j] = gs[4 + j] * ((acc[ai][0][m][1][j] + ba1[j]) * fast_sigmoid(acc[ai][1][m][1][j] + bg1[j])) + pm[4 + j];
                }
                *(u32x4*)(MG + (size_t)row * DM + col) = pack8(v);
            }
    }
};
struct GroupOrder {
    int G, c;
    __device__ __forceinline__ bool next(int i, Unit& u) const { const int L = i * G + c; if (L >= 512) return false; const int g = L >> 4, r = L & 15; u.pm = g * 9 + (r >> 1); u.pn = g * 2 + (r & 1); return true; }
    __device__ __forceinline__ void a_ready(const Unit&) const {}
    __device__ __forceinline__ void done(const Unit&) const {}
};

struct PoolOrder {
    int G, c;
    __device__ __forceinline__ bool next(int i, Unit& u) const { const int L = i * G + c; if (L >= 258 * 4) return false; const int pn = L & 3, pm = L >> 2; u.pm = (pn >> 1) * 258 + pm; u.pn = pn; return true; }
    __device__ __forceinline__ void a_ready(const Unit&) const {}
    __device__ __forceinline__ void done(const Unit&) const {}
};
template <int K, int NOUT, int MODE, int HO>
__device__ __forceinline__ void conv_weight(LAS float* tile, const float* __restrict__ W, bf16_t* __restrict__ Wt, const float* __restrict__ rowg, int tid, int bid, int nb) {
    constexpr int TK = K / 64, TS = NOUT / 256;
    const int kr = tid >> 4, nc = (tid & 15) * 4;
    for (int t = bid; t < TK * TS; t += nb) {
        const int kt = t % TK, ns = t / TK, k0 = kt * 64;
        f32x4 v[4][2];
#pragma unroll
        for (int s4 = 0; s4 < 4; ++s4) {
            const int s0 = (MODE == 1) ? ((s4 >> 1) * HO + 128 * ns + (s4 & 1) * 64) : (ns * 256 + s4 * 64);
#pragma unroll
            for (int p = 0; p < 2; ++p) v[s4][p] = *(const f32x4*)(W + (size_t)(k0 + kr + 32 * p) * NOUT + s0 + nc);
        }
        const float g0 = rowg ? rowg[k0 + kr] : 1.0f, g1 = rowg ? rowg[k0 + kr + 32] : 1.0f;
#pragma unroll
        for (int s4 = 0; s4 < 4; ++s4)
#pragma unroll
            for (int p = 0; p < 2; ++p) { const float gk = p ? g1 : g0; LAS float* tp = tile + s4 * 4160 + (kr + 32 * p) * 65 + nc;
                tp[0] = v[s4][p][0] * gk; tp[1] = v[s4][p][1] * gk; tp[2] = v[s4][p][2] * gk; tp[3] = v[s4][p][3] * gk; }
        __syncthreads();
        const int n = tid >> 3, k8 = (tid & 7) * 8;
#pragma unroll
        for (int s4 = 0; s4 < 4; ++s4) {
            float o[8];
#pragma unroll
            for (int i = 0; i < 8; ++i) o[i] = tile[s4 * 4160 + (k8 + i) * 65 + n];
            *(u32x4*)(Wt + (size_t)(ns * 256 + s4 * 64 + n) * K + k0 + k8) = pack8(o);
        }
        __syncthreads();
    }
}

template <int MODE, int NR>
__device__ __forceinline__ void row_phase(const Params& p, const float* __restrict__ sumsq, const float* __restrict__ gain, float* __restrict__ rstd_out, const float* __restrict__ rstd0, const int rbeg, const int rend, int gw, int nw, int lane) {
    const bf16_t* R = (const bf16_t*)(p.ws + WS_R); bf16_t* H = (bf16_t*)(p.ws + WS_H); bf16_t* XNo = (bf16_t*)(p.ws + WS_XN);
    const bf16_t* B = (MODE == 1) ? (const bf16_t*)H : (const bf16_t*)(p.ws + WS_XN);
    const float scale = (MODE == 1) ? 1.0f : 0.5f;
    float g[2][8];
#pragma unroll
    for (int i = 0; i < 2; ++i) { const f32x4 a = *(const f32x4*)(gain + i * 512 + lane * 8), b = *(const f32x4*)(gain + i * 512 + lane * 8 + 4);
#pragma unroll
        for (int j = 0; j < 4; ++j) { g[i][j] = a[j] * scale; g[i][4 + j] = b[j] * scale; } }
    for (int row0 = rbeg + gw; row0 < rend; row0 += NR * nw) {
        u32x4 rw[NR][2], hw[NR][2]; float sq[NR], bs[NR];
#pragma unroll
        for (int q = 0; q < NR; ++q) {
            const int row = (row0 + q * nw < rend) ? row0 + q * nw : row0;
            sq[q] = sumsq[row]; bs[q] = (MODE != 1) ? rstd0[row] : 1.0f;
#pragma unroll
            for (int i = 0; i < 2; ++i) { const size_t off = (size_t)row * DM + i * 512 + lane * 8; rw[q][i] = __builtin_nontemporal_load((const u32x4*)(R + off)); hw[q][i] = __builtin_nontemporal_load((const u32x4*)(B + off)); }
        }
#pragma unroll
        for (int q = 0; q < NR; ++q) {
            const int row = row0 + q * nw;
            if (row >= rend) break;
            const float rstd = rsqrtf(sq[q] * (1.0f / 1024.0f) + EPS);
            const float binv = (MODE != 1) ? 1.0f / bs[q] : 1.0f;
            float ss = 0.f; float hk[2][8];
#pragma unroll
            for (int i = 0; i < 2; ++i) {
                const size_t off = (size_t)row * DM + i * 512 + lane * 8;
                float r[8], b[8]; float (&h)[8] = hk[i]; unpack8(rw[q][i], r); unpack8(hw[q][i], b);
#pragma unroll
                for (int j = 0; j < 8; ++j) { h[j] = b[j] * binv + r[j] * rstd * g[i][j]; ss += h[j] * h[j]; }
                if (MODE == 2) { float* o = p.out + OUT_Y + off; __builtin_nontemporal_store((f32x4){h[0], h[1], h[2], h[3]}, (f32x4*)o); __builtin_nontemporal_store((f32x4){h[4], h[5], h[6], h[7]}, (f32x4*)(o + 4)); }
                else if (MODE == 0) *(u32x4*)(H + off) = pack8(h);
            }
            if (MODE != 2) { ss = wave_sum(ss); const float rs = rsqrtf(ss * (1.0f / 1024.0f) + EPS);
                if (lane == 0) rstd_out[row] = rs;
                if (MODE == 1) {
#pragma unroll
                    for (int i = 0; i < 2; ++i) { float z[8];
#pragma unroll
                        for (int j = 0; j < 8; ++j) z[j] = hk[i][j] * rs;
                        *(u32x4*)(XNo + (size_t)row * DM + i * 512 + lane * 8) = pack8(z); } } }
        }
    }
}

template <int K>
__device__ __forceinline__ void small_down(LAS float* red, const bf16_t* __restrict__ A, const bf16_t* __restrict__ Bt, bf16_t* __restrict__ O, float* sumsq, int bid, int nb, int tid, int wid, int lane) {
    constexpr int KW = K / 8;
    for (int task = bid; task < 256; task += nb) {
        const int rb = task >> 4, cb = task & 15;
        const bf16_t* Ap = A + (size_t)(MP + rb * 32 + (lane & 31)) * K + wid * KW + 8 * (lane >> 5);
        const bf16_t* Bp = Bt + (size_t)(cb * 64 + (lane & 31)) * K + wid * KW + 8 * (lane >> 5);
        f32x16 acc0, acc1;
#pragma unroll
        for (int j = 0; j < 16; ++j) { acc0[j] = 0.f; acc1[j] = 0.f; }
#pragma unroll 4
        for (int k0 = 0; k0 < KW; k0 += 16) {
            const bf16x8 a = *(const bf16x8*)(Ap + k0), b0 = *(const bf16x8*)(Bp + k0), b1 = *(const bf16x8*)(Bp + (size_t)32 * K + k0);
            acc0 = __builtin_amdgcn_mfma_f32_32x32x16_bf16(a, b0, acc0, 0, 0, 0); acc1 = __builtin_amdgcn_mfma_f32_32x32x16_bf16(a, b1, acc1, 0, 0, 0);
        }
#pragma unroll
        for (int j = 0; j < 16; ++j) { red[((wid * 2 + 0) * 16 + j) * 64 + lane] = acc0[j]; red[((wid * 2 + 1) * 16 + j) * 64 + lane] = acc1[j]; }
        __syncthreads();
#pragma unroll
        for (int i = 0; i < 4; ++i) {
            const int idx = tid + 512 * i; float s = 0.f;
#pragma unroll
            for (int w = 0; w < 8; ++w) s += red[w * 2048 + idx];
            const int q = idx >> 10, j = (idx >> 6) & 15;
            const int row = MP + rb * 32 + (j & 3) + 8 * (j >> 2) + 4 * (lane >> 5), col = cb * 64 + 32 * q + (lane & 31);
            O[(size_t)row * DM + col] = (bf16_t)(cvt_pk_bf16(s, 0.f) & 0xffffu);
            float sq = s * s;
            sq += __shfl_xor(sq, 16); sq += __shfl_xor(sq, 8); sq += __shfl_xor(sq, 4); sq += __shfl_xor(sq, 2); sq += __shfl_xor(sq, 1);
            if ((lane & 31) == 0) atomicAdd(sumsq + row, sq);
        }
        __syncthreads();
    }
}


__device__ __forceinline__ void small_ssm(const bf16_t* __restrict__ U, const bf16_t* __restrict__ Bt, bf16_t* __restrict__ YG, const float* __restrict__ dskip, int gw, int nw, int lane) {
    for (int task = gw; task < 32 * 16; task += nw) {
        const int g = task >> 4, cb = task & 15;
        const bf16_t* Ap = U + (size_t)(g * CRP + 2048 + (lane & 31)) * KS + 8 * (lane >> 5);
        const bf16_t* Bp = Bt + (size_t)(g * 512 + cb * 32 + (lane & 31)) * KS + 8 * (lane >> 5);
        f32x16 acc;
#pragma unroll
        for (int j = 0; j < 16; ++j) acc[j] = 0.f;
#pragma unroll 8
        for (int k0 = 0; k0 < KS; k0 += 16) { const bf16x8 a = *(const bf16x8*)(Ap + k0), b = *(const bf16x8*)(Bp + k0); acc = __builtin_amdgcn_mfma_f32_32x32x16_bf16(a, b, acc, 0, 0, 0); }
        const int col = cb * 32 + (lane & 31), t = col >> 4, c = col & 15; const float d = dskip[g * 16 + c];
#pragma unroll
        for (int j = 0; j < 8; ++j) {
            const int cr = 2048 + (j & 3) + 8 * (j >> 2) + 4 * (lane >> 5);
            const float uu = __uint_as_float((unsigned)U[(size_t)(g * CRP + cr) * KS + col] << 16);
            const float x = acc[j] + d * uu, v = x * fast_sigmoid(1.5957691216f * (x + 0.044715f * x * x * x));
            YG[(size_t)(cr * 32 + t) * 512 + g * 16 + c] = (bf16_t)(cvt_pk_bf16(v, 0.f) & 0xffffu);
        }
    }
}

__device__ __forceinline__ void grid_barrier(unsigned* bar, unsigned epoch, int bid, int nb, int tid) {
    asm volatile("s_waitcnt vmcnt(0) lgkmcnt(0)" ::: "memory");
    __syncthreads();
    if (tid == 0) {
        __builtin_amdgcn_fence(__ATOMIC_RELEASE, "agent"); asm volatile("s_waitcnt vmcnt(0)" ::: "memory");
        const int j = bid & 7; const unsigned ng = (unsigned)((nb - j + 7) >> 3);
        const unsigned old = __hip_atomic_fetch_add(bar + 64 * j, 1u, __ATOMIC_RELAXED, __HIP_MEMORY_SCOPE_AGENT);
        if (old == ng * epoch - 1u) {
            const unsigned ngroups = (unsigned)(nb < 8 ? nb : 8);
            const unsigned oldt = __hip_atomic_fetch_add(bar + 64 * 8, 1u, __ATOMIC_RELAXED, __HIP_MEMORY_SCOPE_AGENT);
            if (oldt == ngroups * epoch - 1u) {
#pragma unroll
                for (int q = 0; q < 8; ++q) __hip_atomic_store(bar + 64 * (9 + q), epoch, __ATOMIC_RELAXED, __HIP_MEMORY_SCOPE_AGENT);
            }
        }
        unsigned spins = 0;
        while (__hip_atomic_load(bar + 64 * (9 + j), __ATOMIC_RELAXED, __HIP_MEMORY_SCOPE_AGENT) < epoch) { __builtin_amdgcn_s_sleep(1); if (++spins > (1u << 24)) break; }
        __builtin_amdgcn_fence(__ATOMIC_ACQUIRE, "agent"); asm volatile("s_waitcnt vmcnt(0)" ::: "memory");
    }
    __syncthreads();
}

__device__ __forceinline__ void p0_xn(const Params& p, bf16_t* __restrict__ XN, float* __restrict__ RSTD, const int rbeg, const int rend, const int gw, const int nw, const int lane) {
        for (int row0 = rbeg + gw; row0 < rend; row0 += 2 * nw) {
            const bool two = (row0 + nw) < rend;
            f32x4 v[2][4];
#pragma unroll
            for (int q = 0; q < 2; ++q) { const int row = (q == 0 || two) ? row0 + q * nw : row0;
                const float* xr = (row < MP) ? (p.in[0] + (size_t)row * DM) : (p.in[1] + (size_t)(row - MP) * DM);
#pragma unroll
                for (int i = 0; i < 4; ++i) v[q][i] = __builtin_nontemporal_load((const f32x4*)(xr + i * 256 + lane * 4)); }
#pragma unroll
            for (int q = 0; q < 2; ++q) {
                if (q == 1 && !two) break;
                const int row = row0 + q * nw; float ss = 0.f;
#pragma unroll
                for (int i = 0; i < 4; ++i) ss += v[q][i][0] * v[q][i][0] + v[q][i][1] * v[q][i][1] + v[q][i][2] * v[q][i][2] + v[q][i][3] * v[q][i][3];
                ss = wave_sum(ss);
                const float rs = rsqrtf(ss * (1.0f / 1024.0f) + EPS);
                if (lane == 0) RSTD[row] = rs;
#pragma unroll
                for (int i = 0; i < 4; ++i) { typedef unsigned u32x2 __attribute__((ext_vector_type(2))); u32x2 w; w.x = cvt_pk_bf16(v[q][i][0] * rs, v[q][i][1] * rs); w.y = cvt_pk_bf16(v[q][i][2] * rs, v[q][i][3] * rs);
                    *(u32x2*)(XN + (size_t)row * DM + i * 256 + lane * 4) = w; }
            }
        }
}

__device__ __forceinline__ void sub_barrier(unsigned* word, unsigned count, int tid) {
    asm volatile("s_waitcnt vmcnt(0) lgkmcnt(0)" ::: "memory");
    __syncthreads();
    if (tid == 0) {
        __builtin_amdgcn_fence(__ATOMIC_RELEASE, "agent"); asm volatile("s_waitcnt vmcnt(0)" ::: "memory");
        __hip_atomic_fetch_add(word, 1u, __ATOMIC_RELAXED, __HIP_MEMORY_SCOPE_AGENT);
        unsigned spins = 0;
        while (__hip_atomic_load(word, __ATOMIC_RELAXED, __HIP_MEMORY_SCOPE_AGENT) < count) { __builtin_amdgcn_s_sleep(1); if (++spins > (1u << 24)) break; }
        __builtin_amdgcn_fence(__ATOMIC_ACQUIRE, "agent"); asm volatile("s_waitcnt vmcnt(0)" ::: "memory");
    }
    __syncthreads();
}
struct OneUnit {
    int pm, pn;
    __device__ __forceinline__ bool next(int i, Unit& u) const { if (i != 0) return false; u.pm = pm; u.pn = pn; return true; }
    __device__ __forceinline__ void a_ready(const Unit&) const {}
    __device__ __forceinline__ void done(const Unit&) const {}
};
#define GRID_SYNC() grid_barrier((unsigned*)(ws + WS_BAR), ++epoch, bid, nb, tid)
#define GRID_SYNC_CG() do { asm volatile("s_waitcnt vmcnt(0) lgkmcnt(0)" ::: "memory"); __syncthreads(); if (wid == 0) { __builtin_amdgcn_fence(__ATOMIC_RELEASE, "agent"); asm volatile("s_waitcnt vmcnt(0)" ::: "memory"); } grid.sync(); __builtin_amdgcn_fence(__ATOMIC_ACQUIRE, "agent"); asm volatile("s_waitcnt vmcnt(0)" ::: "memory"); } while (0)
__device__ __forceinline__ void pooled_row(float (&v)[8], int tt, int r0, int oct, int pos0, bool smp, const bf16_t* __restrict__ UP, const float* __restrict__ cache) {
    if (tt >= 0 || (!smp && pos0 + tt >= 0)) unpack8(*(const u32x4*)(UP + (size_t)(r0 + tt) * 512 + oct * 8), v);
    else if (smp) { const f32x4 a = *(const f32x4*)(cache + (size_t)(15 + tt) * 512), b = *(const f32x4*)(cache + (size_t)(15 + tt) * 512 + 4);
#pragma unroll
        for (int j = 0; j < 4; ++j) { v[j] = a[j]; v[4 + j] = b[j]; } }
    else {
#pragma unroll
        for (int j = 0; j < 8; ++j) v[j] = 0.f; }
}
__device__ __forceinline__ void pooled_task(const int i, const int tb, const int nrows, const bf16_t* __restrict__ UP, bf16_t* __restrict__ POOLED, const Params& p) {
    const int oct = i & 63, cr = i >> 6, gi = oct >> 4, w = 2 << gi, r0 = cr * 32;
    const bool smp = cr >= 2048; const int pos0 = smp ? 2048 : (cr & 255) * 32;
    const float* cache = p.in[4] + (size_t)(cr - 2048) * 15 * 512 + oct * 8;
    float S[8];
#pragma unroll
    for (int j = 0; j < 8; ++j) S[j] = 0.f;
    for (int tt = tb + 1 - w; tt < tb; ++tt) {
        float v[8]; pooled_row(v, tt, r0, oct, pos0, smp, UP, cache);
#pragma unroll
        for (int j = 0; j < 8; ++j) S[j] += v[j];
    }
    for (int t0 = tb; t0 < tb + nrows; t0 += 8) {
        float cur[8][8], old[8][8];
#pragma unroll
        for (int q = 0; q < 8; ++q) { pooled_row(cur[q], t0 + q, r0, oct, pos0, smp, UP, cache);
            if (t0 + q > tb) pooled_row(old[q], t0 + q - w, r0, oct, pos0, smp, UP, cache);
            else {
#pragma unroll
                for (int j = 0; j < 8; ++j) old[q][j] = 0.f; } }
#pragma unroll
        for (int q = 0; q < 8; ++q) {
            const int pos = pos0 + t0 + q; const float inv = 1.0f / (float)((pos + 1 < w) ? (pos + 1) : w);
            float o[8];
#pragma unroll
            for (int j = 0; j < 8; ++j) { S[j] += cur[q][j] - old[q][j]; o[j] = S[j] * inv - cur[q][j]; }
            *(u32x4*)(POOLED + ((size_t)(oct >> 5) * MT + (size_t)(r0 + t0 + q)) * 256 + (oct & 31) * 8) = pack8(o);
        }
    }
}
#define POOLED_TASK(i) pooled_task((i), 0, 32, UP, POOLED, p)
__global__ void __launch_bounds__(512) fwd_megakernel(Params p) {
    extern __shared__ __attribute__((aligned(16))) unsigned char shm[];
    cg::grid_group grid = cg::this_grid();
    LAS unsigned char* lds = (LAS unsigned char*)shm;
    const int tid = threadIdx.x, lane = tid & 63, wid = __builtin_amdgcn_readfirstlane(tid >> 6);
    const int bid = blockIdx.x, nb = gridDim.x, gw = bid * 8 + wid, nw = nb * 8, gt = bid * 512 + tid, nt = nb * 512;
    unsigned char* ws = p.ws; unsigned char* dob = (unsigned char*)p.out; unsigned epoch = 0u;
    bf16_t* XN = (bf16_t*)(ws + WS_XN); bf16_t* HID = (bf16_t*)(ws + WS_HID); bf16_t* R = (bf16_t*)(ws + WS_R);
    bf16_t* GATES = (bf16_t*)(ws + WS_GATES); bf16_t* POOLED = (bf16_t*)(ws + WS_POOLED); bf16_t* UP = (bf16_t*)(ws + WS_UP); bf16_t* PMb = (bf16_t*)(ws + WS_PM);
    bf16_t* MERGED = (bf16_t*)(ws + WS_MERGED); float* Eb = (float*)(ws + WS_E);
    bf16_t* Uq = (bf16_t*)(dob + DO_U); bf16_t* YG = (bf16_t*)(dob + DO_YG);
    bf16_t* W1IN = (bf16_t*)(ws + WS_W1IN); bf16_t* W1OUT = (bf16_t*)(ws + WS_W1OUT); bf16_t* WIN = (bf16_t*)(ws + WS_WIN); bf16_t* WGLU = (bf16_t*)(ws + WS_WGLU);
    bf16_t* WPOOL = (bf16_t*)(ws + WS_WPOOL); bf16_t* WOUT = (bf16_t*)(ws + WS_WOUT); bf16_t* W2IN = (bf16_t*)(ws + WS_W2IN); bf16_t* W2OUT = (bf16_t*)(ws + WS_W2OUT);
    bf16_t* SSMBT = (bf16_t*)(ws + WS_SSMBT); bf16_t* WEND = (bf16_t*)(ws + WS_WEND);
    float* RSTD = (float*)(ws + WS_RSTD); bf16_t* Hb = (bf16_t*)(ws + WS_H);
    float* KLAG = (float*)(ws + WS_KLAG); float* LP = (float*)(ws + WS_LP); float* BB = (float*)(ws + WS_BB); float* SUMSQ = (float*)(ws + WS_SUMSQ);

    {
        {
            constexpr int NS1 = 44;
            LAS float* tile = (LAS float*)lds;
            if (bid < NS1) {
                conv_weight<1024, 5632, 1, 2816>(tile, p.in[6], W1IN, p.in[5], tid, bid, NS1);
                p0_xn(p, XN, RSTD, MP, MT, bid * 8 + wid, NS1 * 8, lane);
                sub_barrier((unsigned*)(ws + WS_BAR) + 64 * 19, NS1, tid);
                { pg8::Gemm g{XN, W1IN, MT, 2 * DFF, DM}; OneUnit S{256 + bid / 22, bid % 22}; EpiFfnUp E{HID}; pg8::gemm_phase<EpiFfnUp, OneUnit, false>(lds, g, S, E, nullptr); }
                conv_weight<2816, 1024, 0, 0>(tile, p.in[7], W1OUT, nullptr, tid, bid, NS1);
            } else {
                conv_weight<1024, 3072, 0, 0>(tile, p.in[10], WIN, p.in[9], tid, bid - NS1, nb - NS1);
                p0_xn(p, XN, RSTD, 0, MP, (bid - NS1) * 8 + wid, (nb - NS1) * 8, lane);
            }
        }
        for (int i = gt; i < 1024 * 32; i += nt) {
            const int n = i >> 5, k8 = (i & 31) * 8, gi = n >> 8, ch = (gi >> 1) * 256 + k8; float v[8];
#pragma unroll
            for (int j = 0; j < 8; ++j) v[j] = 0.f;
            if ((ch >> 7) == gi) { const float sc = p.in[23][n];
#pragma unroll
                for (int j = 0; j < 8; ++j) v[j] = p.in[22][(size_t)gi * 32768 + (size_t)((ch & 127) + j) * 256 + (n & 255)] * sc; }
            *(u32x4*)(WPOOL + (size_t)n * 256 + k8) = pack8(v);
        }
        for (int i = gt; i < 32 * 33 * 64; i += nt) {
            const int pp = i & 63, j = (i >> 6) % 33, g = i / (33 * 64);
            const float dt = expf(p.in[14][g]), lr = p.in[12][g * 64 + pp], li = p.in[13][g * 64 + pp];
            const float mag = expf((float)j * lr * dt);
            const double turns = (double)j * ((double)li * (double)dt) * 0.15915494309189533577;
            const float fr = (float)(turns - rint(turns));
            LP[(size_t)i * 2] = mag * __builtin_amdgcn_cosf(fr); LP[(size_t)i * 2 + 1] = mag * __builtin_amdgcn_sinf(fr);
        }
        for (int i = gt; i < 32 * 64; i += nt) {
            const int pp = i & 63, g = i >> 6;
            const float dt = expf(p.in[14][g]), lr = p.in[12][i], li = p.in[13][i];
            const float mag = expf(lr * dt);
            const double turns = ((double)li * (double)dt) * 0.15915494309189533577;
            const float fr = (float)(turns - rint(turns));
            const float abr = mag * __builtin_amdgcn_cosf(fr), abi = mag * __builtin_amdgcn_sinf(fr);
            const float den = lr * lr + li * li, nr = abr - 1.0f;
            const float fre = (nr * lr + abi * li) / den, fim = (abi * lr - nr * li) / den;
#pragma unroll
            for (int c4 = 0; c4 < 4; ++c4) {
                const f32x4 br = *(const f32x4*)(p.in[15] + (size_t)i * 16 + c4 * 4), bi = *(const f32x4*)(p.in[16] + (size_t)i * 16 + c4 * 4);
                f32x4 o0, o1;
                o0[0] = fre * br[0] - fim * bi[0]; o0[1] = fre * bi[0] + fim * br[0]; o0[2] = fre * br[1] - fim * bi[1]; o0[3] = fre * bi[1] + fim * br[1];
                o1[0] = fre * br[2] - fim * bi[2]; o1[1] = fre * bi[2] + fim * br[2]; o1[2] = fre * br[3] - fim * bi[3]; o1[3] = fre * bi[3] + fim * br[3];
                *(f32x4*)(BB + ((size_t)i * 16 + c4 * 4) * 2) = o0; *(f32x4*)(BB + ((size_t)i * 16 + c4 * 4) * 2 + 4) = o1;
            }
            (void)pp;
        }
        for (int i = gt; i < 3 * MT; i += nt) SUMSQ[i] = 0.f;
        if (gt < 64) ((unsigned*)(ws + WS_FLAGS))[gt] = 0u;
    }
    if (nb == 0) grid.sync();
    GRID_SYNC();

    { pg8::Gemm g{XN, W1IN, MP, 2 * DFF, DM}; pg8::StaticOrder S; S.init(MP, 2 * DFF, nb, bid); EpiFfnUp E{HID}; pg8::gemm_phase<EpiFfnUp, pg8::StaticOrder, false>(lds, g, S, E, nullptr); }
    {
        for (int task = gw; task < 32 * 32; task += nw) {
            const int g = task >> 5, j = task & 31, c2 = lane & 15, c1b = lane >> 4;
            const float lpr = LP[((size_t)(g * 33 + j) * 64 + lane) * 2], lpi = LP[((size_t)(g * 33 + j) * 64 + lane) * 2 + 1];
            float a0 = 0.f, a1 = 0.f, a2 = 0.f, a3 = 0.f;
#pragma unroll 4
            for (int pp = 0; pp < 64; ++pp) {
                const float lre = __shfl(lpr, pp), lim = __shfl(lpi, pp);
                const float bre = BB[((size_t)(g * 64 + pp) * 16 + c2) * 2], bim = BB[((size_t)(g * 64 + pp) * 16 + c2) * 2 + 1];
                const float tr = lre * bre - lim * bim, ti = lre * bim + lim * bre;
                const size_t cb = (size_t)(g * 16 + c1b) * 64 + pp;
                a0 += p.in[17][cb] * tr - p.in[18][cb] * ti;
                a1 += p.in[17][cb + 4 * 64] * tr - p.in[18][cb + 4 * 64] * ti;
                a2 += p.in[17][cb + 8 * 64] * tr - p.in[18][cb + 8 * 64] * ti;
                a3 += p.in[17][cb + 12 * 64] * tr - p.in[18][cb + 12 * 64] * ti;
            }
            float* kd = KLAG + (size_t)task * 256 + c2;
            kd[(c1b) * 16] = a0; kd[(c1b + 4) * 16] = a1; kd[(c1b + 8) * 16] = a2; kd[(c1b + 12) * 16] = a3;
        }
        for (int i = gt; i < 32 * 128 * 64; i += nt) {
            const int k8 = (i & 63) * 8, pq = (i >> 6) & 127, g = i >> 13, t1 = k8 >> 4, c20 = k8 & 15, pp = pq & 63;
            const float lre = LP[((size_t)(g * 33 + 31 - t1) * 64 + pp) * 2], lim = LP[((size_t)(g * 33 + 31 - t1) * 64 + pp) * 2 + 1];
            const f32x4* bp = (const f32x4*)(BB + ((size_t)(g * 64 + pp) * 16 + c20) * 2);
            float v[8];
#pragma unroll
            for (int q = 0; q < 4; ++q) { const f32x4 b = bp[q];
                v[2 * q] = (pq < 64) ? (lre * b[0] - lim * b[1]) : (lre * b[1] + lim * b[0]);
                v[2 * q + 1] = (pq < 64) ? (lre * b[2] - lim * b[3]) : (lre * b[3] + lim * b[2]); }
            *(u32x4*)(WEND + (size_t)(g * 128 + pq) * 512 + k8) = pack8(v);
        }
        for (int i = gt; i < 32 * 512 * 16; i += nt) {
            const int pq8 = (i & 15) * 8, n = (i >> 4) & 511, g = i >> 13, t = n >> 4, c1 = n & 15, pp0 = pq8 & 63;
            const f32x4* crp = (const f32x4*)(p.in[17] + (size_t)(g * 16 + c1) * 64 + pp0); const f32x4* cip = (const f32x4*)(p.in[18] + (size_t)(g * 16 + c1) * 64 + pp0);
            const f32x4* lp4 = (const f32x4*)(LP + ((size_t)(g * 33 + t + 1) * 64 + pp0) * 2);
            float v[8];
#pragma unroll
            for (int q = 0; q < 2; ++q) { const f32x4 cr = crp[q], ci = cip[q], l0 = lp4[2 * q], l1 = lp4[2 * q + 1];
                const float lre[4] = {l0[0], l0[2], l1[0], l1[2]}, lim[4] = {l0[1], l0[3], l1[1], l1[3]};
#pragma unroll
                for (int j = 0; j < 4; ++j) v[4 * q + j] = (pq8 < 64) ? (cr[j] * lre[j] - ci[j] * lim[j]) : -(cr[j] * lim[j] + ci[j] * lre[j]); }
            *(u32x4*)(SSMBT + (size_t)(g * 512 + n) * KS + 512 + pq8) = pack8(v);
        }
    }
    GRID_SYNC();

    { pg8::Gemm g{HID, W1OUT, MP, DM, DFF}; pg8::StaticOrder S; S.init(MP, DM, nb, bid); EpiDown E{R, SUMSQ}; pg8::gemm_phase<EpiDown, pg8::StaticOrder, false>(lds, g, S, E, nullptr); }
    small_down<DFF>((LAS float*)lds, HID, W1OUT, R, SUMSQ, bid, nb, tid, wid, lane);
    for (int i = gt; i < 32 * 512 * 64; i += nt) {
        const int k8 = (i & 63) * 8, n = (i >> 6) & 511, g = i >> 15, t = n >> 4, c1 = n & 15, t1 = k8 >> 4, c20 = k8 & 15; float v[8];
#pragma unroll
        for (int j = 0; j < 8; ++j) v[j] = 0.f;
        if (t1 <= t) { const f32x4* kp = (const f32x4*)(KLAG + (size_t)((g * 32 + (t - t1)) * 16 + c1) * 16 + c20); const f32x4 a = kp[0], b = kp[1];
#pragma unroll
            for (int j = 0; j < 4; ++j) { v[j] = a[j]; v[4 + j] = b[j]; } }
        *(u32x4*)(SSMBT + (size_t)(g * 512 + n) * KS + k8) = pack8(v);
    }
    GRID_SYNC();

    {
        constexpr int NS3 = 24;
        if (bid < NS3) {
            row_phase<0, 4>(p, SUMSQ, p.in[8], RSTD + MT, RSTD, MP, MT, bid * 8 + wid, NS3 * 8, lane);
            sub_barrier((unsigned*)(ws + WS_BAR) + 64 * 17, NS3, tid);
            pg8::Gemm g{Hb, WIN, MT, NPROJ, DM}; OneUnit S{256 + bid / 12, bid % 12}; EpiInProj E{Uq, UP, GATES, p.in[11], p.out, RSTD + MT};
            pg8::gemm_phase<EpiInProj, OneUnit, false>(lds, g, S, E, nullptr);
            { LAS float* tile = (LAS float*)lds;
              conv_weight<512, 2048, 1, 1024>(tile, p.in[20], WGLU, nullptr, tid, bid, NS3);
              conv_weight<1024, 1024, 0, 0>(tile, p.in[24], WOUT, nullptr, tid, bid, NS3); }
        } else row_phase<0, 4>(p, SUMSQ, p.in[8], RSTD + MT, RSTD, 0, MP, (bid - NS3) * 8 + wid, (nb - NS3) * 8, lane);
    }
    GRID_SYNC();

    { pg8::Gemm g{Hb, WIN, MP, NPROJ, DM}; pg8::StaticOrder S; S.init(MP, NPROJ, nb, bid); EpiInProj E{Uq, UP, GATES, p.in[11], p.out, RSTD + MT}; pg8::gemm_phase<EpiInProj, pg8::StaticOrder, false>(lds, g, S, E, nullptr); }
    GRID_SYNC();

    {
        for (int task = gw; task < 32 * 64; task += nw) {
            const int g = task >> 6, cr0 = (task & 63) * 32;
            f32x16 acc[4];
#pragma unroll
            for (int q = 0; q < 4; ++q)
#pragma unroll
                for (int j = 0; j < 16; ++j) acc[q][j] = 0.f;
            const bf16_t* Ab = Uq + ((size_t)(g * CRP + cr0 + (lane & 31)) * KS + 8 * (lane >> 5));
            const bf16_t* Bb = WEND + ((size_t)(g * 128 + (lane & 31)) * 512 + 8 * (lane >> 5));
#pragma unroll 4
            for (int k0 = 0; k0 < 512; k0 += 16) {
                const bf16x8 a = *(const bf16x8*)(Ab + k0);
#pragma unroll
                for (int q = 0; q < 4; ++q) { const bf16x8 b = *(const bf16x8*)(Bb + (size_t)q * 32 * 512 + k0); acc[q] = __builtin_amdgcn_mfma_f32_32x32x16_bf16(a, b, acc[q], 0, 0, 0); }
            }
#pragma unroll
            for (int q = 0; q < 4; ++q)
#pragma unroll
                for (int j = 0; j < 16; ++j) { const int row = (j & 3) + 8 * (j >> 2) + 4 * (lane >> 5); Eb[(size_t)(g * CRP + cr0 + row) * 128 + q * 32 + (lane & 31)] = acc[q][j]; }
        }
        for (int i = gt; i < 2048 * 64; i += nt) POOLED_TASK(i);
        for (int i = gt; i < 16 * 64 * 4; i += nt) pooled_task((2048 + (i >> 8)) * 64 + ((i >> 2) & 63), 8 * (i & 3), 8, UP, POOLED, p);
    }
    GRID_SYNC();

    {
        for (int task = gw; task < 8 * 32 + 16 * 32; task += nw) {
            const bool smp = task >= 256; const int tk = smp ? task - 256 : task, b = tk >> 5, g = tk & 31;
            const float l32r = LP[((size_t)(g * 33 + 32) * 64 + lane) * 2], l32i = LP[((size_t)(g * 33 + 32) * 64 + lane) * 2 + 1];
            float sr = 0.f, si = 0.f; int cr = b * 256, nk = 256;
            if (smp) { sr = p.in[2][(size_t)(b * 32 + g) * 64 + lane]; si = p.in[3][(size_t)(b * 32 + g) * 64 + lane]; cr = 2048 + b; nk = 1; }
            if (smp) {
                const size_t base = (size_t)(g * CRP + cr);
                Uq[base * KS + 512 + lane] = (bf16_t)(cvt_pk_bf16(sr, 0.f) & 0xffffu);
                Uq[base * KS + 576 + lane] = (bf16_t)(cvt_pk_bf16(si, 0.f) & 0xffffu);
                float er = 0.f, ei = 0.f;
                { const bf16_t* ur = Uq + base * KS; const bf16_t* wre = WEND + (size_t)(g * 128 + lane) * 512; const bf16_t* wim = wre + (size_t)64 * 512;
                  for (int k = 0; k < 512; k += 8) { float uu[8], a8[8], b8[8]; unpack8(*(const u32x4*)(ur + k), uu); unpack8(*(const u32x4*)(wre + k), a8); unpack8(*(const u32x4*)(wim + k), b8);
                      for (int j = 0; j < 8; ++j) { er += uu[j] * a8[j]; ei += uu[j] * b8[j]; } } }
                const float nr = l32r * sr - l32i * si + er, ni = l32r * si + l32i * sr + ei;
                sr = nr; si = ni;
            } else {
                for (int k0 = 0; k0 < 256; k0 += 16) {
                    float er[16], ei[16];
#pragma unroll
                    for (int q = 0; q < 16; ++q) { const size_t base = (size_t)(g * CRP + cr + k0 + q); er[q] = Eb[base * 128 + lane]; ei[q] = Eb[base * 128 + 64 + lane]; }
#pragma unroll
                    for (int q = 0; q < 16; ++q) {
                        const size_t base = (size_t)(g * CRP + cr + k0 + q);
                        Uq[base * KS + 512 + lane] = (bf16_t)(cvt_pk_bf16(sr, 0.f) & 0xffffu);
                        Uq[base * KS + 576 + lane] = (bf16_t)(cvt_pk_bf16(si, 0.f) & 0xffffu);
                        const float nr = l32r * sr - l32i * si + er[q], ni = l32r * si + l32i * sr + ei[q];
                        sr = nr; si = ni;
                    }
                }
            }
            const size_t o = (size_t)(b * 32 + g) * 64 + lane;
            if (smp) { p.out[OUT_RE_S + o] = sr; p.out[OUT_IM_S + o] = si; } else { p.out[OUT_RE_P + o] = sr; p.out[OUT_IM_P + o] = si; }
        }
    }
    {
        const int sb = (nb > 64) ? 32 : 0;
        if (bid >= sb) {
        { int kpool = 256; asm volatile("" : "+s"(kpool));
          pg8::Gemm g{POOLED, WPOOL, 2 * MT, DM, kpool}; PoolOrder S{nb - sb, bid - sb}; EpiPool E{GATES, PMb}; pg8::gemm_phase<EpiPool, PoolOrder, false>(lds, g, S, E, nullptr); }
        }
    }
    GRID_SYNC();

    { pg8::Gemm g{Uq, SSMBT, 32 * CRP, 32 * 512, KS}; GroupOrder S{nb, bid}; EpiSsm E{Uq, YG, p.in[19]}; pg8::gemm_phase<EpiSsm, GroupOrder, false>(lds, g, S, E, nullptr); }
    small_ssm(Uq, SSMBT, YG, p.in[19], gw, nw, lane);
    GRID_SYNC();

    { pg8::Gemm g{YG, WGLU, MT, 2 * DM, 512}; pg8::StaticOrder S; S.init(MT, 2 * DM, nb, bid); EpiGlu E{GATES, PMb, MERGED, p.in[21]}; pg8::gemm_phase<EpiGlu, pg8::StaticOrder, false>(lds, g, S, E, nullptr); }
    { const int t6 = (258 * 8) % nb;
      if (bid >= t6) { LAS float* tile = (LAS float*)lds;
        conv_weight<1024, 5632, 1, 2816>(tile, p.in[27], W2IN, p.in[26], tid, bid - t6, nb - t6);
        conv_weight<2816, 1024, 0, 0>(tile, p.in[28], W2OUT, nullptr, tid, bid - t6, nb - t6); } }
    GRID_SYNC();

    { pg8::Gemm g{MERGED, WOUT, MP, DM, DM}; pg8::StaticOrder S; S.init(MP, DM, nb, bid); EpiDown E{R, SUMSQ + MT}; pg8::gemm_phase<EpiDown, pg8::StaticOrder, false>(lds, g, S, E, nullptr); }
    small_down<DM>((LAS float*)lds, MERGED, WOUT, R, SUMSQ + MT, bid, nb, tid, wid, lane);
    GRID_SYNC();

    {
        constexpr int NS8 = 44;
        if (bid < NS8) {
            row_phase<1, 4>(p, SUMSQ + MT, p.in[25], RSTD + 2 * MT, nullptr, MP, MT, bid * 8 + wid, NS8 * 8, lane);
            sub_barrier((unsigned*)(ws + WS_BAR) + 64 * 18, NS8, tid);
            pg8::Gemm g{XN, W2IN, MT, 2 * DFF, DM}; OneUnit S{256 + bid / 22, bid % 22}; EpiFfnUp E{HID};
            pg8::gemm_phase<EpiFfnUp, OneUnit, false>(lds, g, S, E, nullptr);
        } else row_phase<1, 4>(p, SUMSQ + MT, p.in[25], RSTD + 2 * MT, nullptr, 0, MP, (bid - NS8) * 8 + wid, (nb - NS8) * 8, lane);
    }
    GRID_SYNC();

    { pg8::Gemm g{XN, W2IN, MP, 2 * DFF, DM}; pg8::StaticOrder S; S.init(MP, 2 * DFF, nb, bid); EpiFfnUp E{HID}; pg8::gemm_phase<EpiFfnUp, pg8::StaticOrder, false>(lds, g, S, E, nullptr); }
    GRID_SYNC();

    { pg8::Gemm g{HID, W2OUT, MP, DM, DFF}; pg8::StaticOrder S; S.init(MP, DM, nb, bid); EpiDown E{R, SUMSQ + 2 * MT}; pg8::gemm_phase<EpiDown, pg8::StaticOrder, false>(lds, g, S, E, nullptr); }
    small_down<DFF>((LAS float*)lds, HID, W2OUT, R, SUMSQ + 2 * MT, bid, nb, tid, wid, lane);
    GRID_SYNC();

    row_phase<2, 4>(p, SUMSQ + 2 * MT, p.in[29], nullptr, RSTD + 2 * MT, 0, MT, gw, nw, lane);
}

extern "C" void kernel_launch(void* const* d_in, const int* in_sizes, int n_in, void* d_out, int out_size, void* d_ws, size_t ws_size, hipStream_t stream) {
    constexpr int LDS_BYTES = pg8::STAGE_BYTES;
    static int grid = 0;
    if (grid == 0) {
        if (n_in != 30 || ws_size < WS_END) { fprintf(stderr, "kernel_launch: expected 30 inputs and >= %zu bytes of workspace; got %d, %zu\n", (size_t)WS_END, n_in, ws_size); grid = -1; return; }
        int dev = 0, cus = 0, per_cu = 0;
        hipGetDevice(&dev); hipDeviceGetAttribute(&cus, hipDeviceAttributeMultiprocessorCount, dev);
        if (hipFuncSetAttribute((const void*)fwd_megakernel, hipFuncAttributeMaxDynamicSharedMemorySize, LDS_BYTES) != hipSuccess) { fprintf(stderr, "kernel_launch: hipFuncSetAttribute failed\n"); grid = -1; return; }
        if (hipOccupancyMaxActiveBlocksPerMultiprocessor(&per_cu, (const void*)fwd_megakernel, 512, LDS_BYTES) != hipSuccess || per_cu < 1) { fprintf(stderr, "kernel_launch: occupancy query says %d blocks per CU\n", per_cu); (void)hipGetLastError(); per_cu = 1; }
        grid = cus;
    }
    if (grid < 0) return;
    Params p{};
    for (int i = 0; i < 30; ++i) p.in[i] = (const float*)d_in[i];
    p.out = (float*)d_out; p.ws = (unsigned char*)d_ws;
    if (hipMemsetAsync((unsigned char*)d_ws + WS_BAR, 0, WS_BAR_BYTES, stream) != hipSuccess) { fprintf(stderr, "kernel_launch: hipMemsetAsync failed\n"); return; }
    void* args[] = {&p};
    hipError_t e = hipLaunchCooperativeKernel((const void*)fwd_megakernel, dim3(grid), dim3(512), args, LDS_BYTES, stream);
    if (e != hipSuccess) fprintf(stderr, "kernel_launch: cooperative launch failed: %s (grid %d)\n", hipGetErrorString(e), grid);
}
```
